# Optimizing an MI355X kernel written in HIP

```python
import jax, jax.numpy as jnp
from jax import lax
import numpy as np

D_MODEL = 1024
BATCH = 8
SEQ = 8192
DEPTH = 2
DEC_BATCH = 8
DEC_SEQ = 32
PAST_LEN = 2048

CHUNK = 64
N_MIXERS = 2
N_RET_LAYERS = (DEPTH + 1) // 2
N_GLA_LAYERS = DEPTH // 2
RET_HEADS = 4
RET_DK = D_MODEL // RET_HEADS
RET_DV = 2 * D_MODEL // RET_HEADS
RET_QK = RET_HEADS * RET_DK
RET_V = RET_HEADS * RET_DV
ROPE_BASE = 10000.0
GLA_HEADS = 4
GLA_DK = D_MODEL // 2 // GLA_HEADS
GLA_DV = D_MODEL // GLA_HEADS
GLA_QK = GLA_HEADS * GLA_DK
GLA_V = GLA_HEADS * GLA_DV
GLA_GATE_RANK = 16
GLA_TAU = 16.0
D_FF = 2816
CONV_W = 3
EPS = 1e-6

kernel_name = "hybrid_retention_gla_convffn_step"


def rmsnorm(x, g):
    xf = x.astype(jnp.float32)
    y = xf * lax.rsqrt(jnp.mean(xf * xf, axis=-1, keepdims=True) + EPS)
    return (y * g.astype(jnp.float32)).astype(x.dtype)


def rotary(x, pos):
    half = x.shape[-1] // 2
    inv = ROPE_BASE ** (-jnp.arange(half, dtype=jnp.float32) / half)
    ang = pos.astype(jnp.float32)[:, None] * inv[None, :]
    cos = jnp.cos(ang)[None, :, None, :]
    sin = jnp.sin(ang)[None, :, None, :]
    x1, x2 = x[..., :half], x[..., half:]
    return jnp.concatenate([x1 * cos - x2 * sin, x1 * sin + x2 * cos], axis=-1)


def run_chunked(step, S0, seqs):
    T = seqs[0].shape[1]
    if T <= CHUNK:
        return step(S0, seqs)
    n = T // CHUNK
    def to_chunks(a):
        return jnp.moveaxis(a.reshape((a.shape[0], n, CHUNK) + a.shape[2:]), 1, 0)
    S, out = lax.scan(step, S0, tuple(to_chunks(a) for a in seqs))
    out = jnp.moveaxis(out, 0, 1)
    return S, out.reshape((out.shape[0], T) + out.shape[3:])


def retention_chunk(S, xs, log_gamma):
    q, k, v = xs
    L = q.shape[1]
    idx = jnp.arange(L, dtype=jnp.float32)
    diff = idx[:, None] - idx[None, :]
    lg = log_gamma[:, None, None]
    decay = jnp.where(diff[None] >= 0.0, jnp.exp(lg * jnp.maximum(diff, 0.0)[None]), 0.0)
    scores = jnp.einsum('bihd,bjhd->bhij', q, k) * decay[None]
    intra = jnp.einsum('bhij,bjhe->bihe', scores, v)
    q_dec = jnp.exp(log_gamma[:, None] * (idx[None, :] + 1.0))
    cross = jnp.einsum('bihd,hi,bhde->bihe', q, q_dec, S)
    k_dec = jnp.exp(log_gamma[:, None] * (L - 1.0 - idx[None, :]))
    S_new = jnp.exp(log_gamma * L)[None, :, None, None] * S + jnp.einsum('bjhd,hj,bjhe->bhde', k, k_dec, v)
    return S_new, intra + cross


def retention_mixer(h, S0, pos, w_in, gn_g, w_out):
    B, T, _ = h.shape
    proj = h @ w_in
    q, k, v, g = jnp.split(proj, [RET_QK, 2 * RET_QK, 2 * RET_QK + RET_V], axis=-1)
    q = rotary(q.astype(jnp.float32).reshape(B, T, RET_HEADS, RET_DK), pos)
    k = rotary(k.astype(jnp.float32).reshape(B, T, RET_HEADS, RET_DK), pos) * (RET_DK ** -0.5)
    v = v.astype(jnp.float32).reshape(B, T, RET_HEADS, RET_DV)
    log_gamma = jnp.log1p(-jnp.exp2(-5.0 - jnp.arange(RET_HEADS, dtype=jnp.float32)))
    step = lambda S, xs: retention_chunk(S, xs, log_gamma)
    S, o = run_chunked(step, S0.astype(jnp.float32), (q, k, v))
    mu = jnp.mean(o, axis=-1, keepdims=True)
    var = jnp.mean(jnp.square(o - mu), axis=-1, keepdims=True)
    o = (o - mu) * lax.rsqrt(var + EPS) * gn_g.astype(jnp.float32)[None, None]
    o = o.reshape(B, T, RET_V).astype(h.dtype)
    return (jax.nn.silu(g) * o) @ w_out, S


def gla_chunk(S, xs):
    q, k, v, lg = xs
    L = q.shape[1]
    b = jnp.cumsum(lg, axis=1)
    causal = jnp.tril(jnp.ones((L, L), dtype=bool))
    expo = b[:, :, None] - b[:, None, :]
    expo = jnp.where(causal[None, :, :, None, None], expo, -jnp.inf)
    A = jnp.einsum('bihd,bjhd,bijhd->bhij', q, k, jnp.exp(expo))
    intra = jnp.einsum('bhij,bjhe->bihe', A, v)
    cross = jnp.einsum('bihd,bhde->bihe', q * jnp.exp(b), S)
    bL = b[:, -1]
    S_new = jnp.exp(bL)[..., None] * S + jnp.einsum('bjhd,bjhe->bhde', k * jnp.exp(bL[:, None] - b), v)
    return S_new, intra + cross


def gla_mixer(h, S0, w_in, w_a2, b_a, norm_g, w_out):
    B, T, _ = h.shape
    proj = h @ w_in
    q, k, v, r, a = jnp.split(proj, [GLA_QK, 2 * GLA_QK, 2 * GLA_QK + GLA_V, 2 * GLA_QK + 2 * GLA_V], axis=-1)
    q = q.astype(jnp.float32).reshape(B, T, GLA_HEADS, GLA_DK)
    k = k.astype(jnp.float32).reshape(B, T, GLA_HEADS, GLA_DK) * (GLA_DK ** -0.5)
    v = v.astype(jnp.float32).reshape(B, T, GLA_HEADS, GLA_DV)
    lg = jax.nn.log_sigmoid((a @ w_a2 + b_a).astype(jnp.float32)) / GLA_TAU
    lg = lg.reshape(B, T, GLA_HEADS, GLA_DK)
    S, o = run_chunked(gla_chunk, S0.astype(jnp.float32), (q, k, v, lg))
    o = o * lax.rsqrt(jnp.mean(o * o, axis=-1, keepdims=True) + EPS) * norm_g.astype(jnp.float32)[None, None]
    o = o.reshape(B, T, GLA_V).astype(h.dtype)
    return (jax.nn.silu(r) * o) @ w_out, S


def conv_ffn(h, conv_state, w_up, conv_w, conv_b, w_down):
    u = h @ w_up
    T = u.shape[1]
    ext = jnp.concatenate([conv_state.astype(u.dtype), u], axis=1)
    c = conv_b + ext[:, 0:T] * conv_w[0]
    for j in range(1, CONV_W):
        c = c + ext[:, j:j + T] * conv_w[j]
    gate, val = jnp.split(c, 2, axis=-1)
    return (jax.nn.silu(gate) * val) @ w_down, ext[:, T:]


def trunk(x, pos, ret_states, gla_states, conv_states,
          norm_mix, norm_ffn, norm_final,
          ret_w_in, ret_gn_g, ret_w_out,
          gla_w_in, gla_w_a2, gla_b_a, gla_norm_g, gla_w_out,
          ffn_w_up, ffn_conv_w, ffn_conv_b, ffn_w_down):
    new_ret, new_gla, new_conv = [], [], []
    for i in range(DEPTH):
        h = rmsnorm(x, norm_mix[i])
        j = i // N_MIXERS
        if i % N_MIXERS == 0:
            y, S = retention_mixer(h, ret_states[j], pos, ret_w_in[j], ret_gn_g[j], ret_w_out[j])
            new_ret.append(S)
        else:
            y, S = gla_mixer(h, gla_states[j], gla_w_in[j], gla_w_a2[j], gla_b_a[j], gla_norm_g[j], gla_w_out[j])
            new_gla.append(S)
        x = x + y
        h = rmsnorm(x, norm_ffn[i])
        y, cs = conv_ffn(h, conv_states[i], ffn_w_up[i], ffn_conv_w[i], ffn_conv_b[i], ffn_w_down[i])
        new_conv.append(cs)
        x = x + y
    return rmsnorm(x, norm_final), jnp.stack(new_ret), jnp.stack(new_gla), jnp.stack(new_conv)


def setup_inputs(seed: int = 0) -> dict:
    key = jax.random.key(seed)
    ks = jax.random.split(key, 24)
    nrm = lambda k, shape, s: jax.random.normal(k, shape, dtype=jnp.float32) * s
    D = D_MODEL
    return {
        "x_prompt": nrm(ks[0], (BATCH, SEQ, D), 1.0),
        "x_sample": nrm(ks[1], (DEC_BATCH, DEC_SEQ, D), 1.0),
        "state_ret": nrm(ks[2], (N_RET_LAYERS, DEC_BATCH, RET_HEADS, RET_DK, RET_DV), 0.5),
        "state_gla": nrm(ks[3], (N_GLA_LAYERS, DEC_BATCH, GLA_HEADS, GLA_DK, GLA_DV), 0.5),
        "cache_conv": nrm(ks[4], (DEPTH, DEC_BATCH, CONV_W - 1, 2 * D_FF), 1.0),
        "norm_mix": 1.0 + nrm(ks[5], (DEPTH, D), 0.02),
        "norm_ffn": 1.0 + nrm(ks[6], (DEPTH, D), 0.02),
        "norm_final": 1.0 + nrm(ks[7], (D,), 0.02),
        "ret_w_in": nrm(ks[8], (N_RET_LAYERS, D, 2 * RET_QK + 2 * RET_V), D ** -0.5),
        "ret_gn_g": 1.0 + nrm(ks[9], (N_RET_LAYERS, RET_HEADS, RET_DV), 0.02),
        "ret_w_out": nrm(ks[10], (N_RET_LAYERS, RET_V, D), RET_V ** -0.5),
        "gla_w_in": nrm(ks[11], (N_GLA_LAYERS, D, 2 * GLA_QK + 2 * GLA_V + GLA_GATE_RANK), D ** -0.5),
        "gla_w_a2": nrm(ks[12], (N_GLA_LAYERS, GLA_GATE_RANK, GLA_QK), GLA_GATE_RANK ** -0.5),
        "gla_b_a": nrm(ks[13], (N_GLA_LAYERS, GLA_QK), 0.01),
        "gla_norm_g": 1.0 + nrm(ks[14], (N_GLA_LAYERS, GLA_HEADS, GLA_DV), 0.02),
        "gla_w_out": nrm(ks[15], (N_GLA_LAYERS, GLA_V, D), GLA_V ** -0.5),
        "ffn_w_up": nrm(ks[16], (DEPTH, D, 2 * D_FF), D ** -0.5),
        "ffn_conv_w": nrm(ks[17], (DEPTH, CONV_W, 2 * D_FF), CONV_W ** -0.5),
        "ffn_conv_b": nrm(ks[18], (DEPTH, 2 * D_FF), 0.01),
        "ffn_w_down": nrm(ks[19], (DEPTH, D_FF, D), D_FF ** -0.5),
    }


def reference(x_prompt, x_sample, state_ret, state_gla, cache_conv,
              norm_mix, norm_ffn, norm_final,
              ret_w_in, ret_gn_g, ret_w_out,
              gla_w_in, gla_w_a2, gla_b_a, gla_norm_g, gla_w_out,
              ffn_w_up, ffn_conv_w, ffn_conv_b, ffn_w_down):
    weights = (norm_mix, norm_ffn, norm_final,
               ret_w_in, ret_gn_g, ret_w_out,
               gla_w_in, gla_w_a2, gla_b_a, gla_norm_g, gla_w_out,
               ffn_w_up, ffn_conv_w, ffn_conv_b, ffn_w_down)
    B = x_prompt.shape[0]
    ret0 = jnp.zeros((N_RET_LAYERS, B, RET_HEADS, RET_DK, RET_DV), jnp.float32)
    gla0 = jnp.zeros((N_GLA_LAYERS, B, GLA_HEADS, GLA_DK, GLA_DV), jnp.float32)
    conv0 = jnp.zeros((DEPTH, B, CONV_W - 1, 2 * D_FF), x_prompt.dtype)
    pos_p = jnp.arange(x_prompt.shape[1], dtype=jnp.int32)
    y_prompt, ret_p, gla_p, conv_p = trunk(x_prompt, pos_p, ret0, gla0, conv0, *weights)
    pos_s = PAST_LEN + jnp.arange(x_sample.shape[1], dtype=jnp.int32)
    y_sample, ret_s, gla_s, conv_s = trunk(x_sample, pos_s, state_ret, state_gla, cache_conv, *weights)
    return (y_prompt, y_sample, ret_p, ret_s, gla_p, gla_s, conv_p, conv_s)
```

```cpp
#include <hip/hip_runtime.h>
#include <hip/hip_cooperative_groups.h>
#include <cstdio>
namespace cg = cooperative_groups;

#ifndef MK_ONE_LAUNCH
#define MK_ONE_LAUNCH 1
#endif

#define LAS __attribute__((address_space(3)))
typedef unsigned short bf16_t;
typedef short bf16x8 __attribute__((ext_vector_type(8)));
typedef short s16x4 __attribute__((ext_vector_type(4)));
typedef float f32x4 __attribute__((ext_vector_type(4)));
typedef float f32x2 __attribute__((ext_vector_type(2)));
typedef unsigned u32x4 __attribute__((ext_vector_type(4)));
typedef unsigned u32x2 __attribute__((ext_vector_type(2)));
typedef __bf16 bf16v2 __attribute__((ext_vector_type(2)));

constexpr int LDS_MAIN = 155648;
constexpr int DM = 1024;
constexpr int MP = 65536;
constexpr int MS = 256;
constexpr int MT_ = MP + MS;
constexpr int SEQ = 8192, DSEQ = 32, PAST = 2048;
constexpr int FF = 2816, FF2 = 5632;
constexpr int RET_N = 6144;
constexpr int GLA_NB = 3072;
constexpr int GLA_N = 3328;
constexpr int NCHUNK = 1032;
constexpr float EPS = 1e-6f;

constexpr size_t O_Y = 0;
constexpr size_t O_RETP = (size_t)MT_ * DM;
constexpr size_t O_RETS = O_RETP + 4194304;
constexpr size_t O_GLAP = O_RETS + 4194304;
constexpr size_t O_GLAS = O_GLAP + 1048576;
constexpr size_t O_CONVP = O_GLAS + 1048576;
constexpr size_t O_CONVS = O_CONVP + 180224;
constexpr size_t O_END = O_CONVS + 180224;

constexpr size_t WS_ROT = 16384;
constexpr size_t WS_WRI = WS_ROT + (size_t)8192 * 128 * 8;
constexpr size_t WS_WRO = WS_WRI + (size_t)RET_N * 1024 * 2;
constexpr size_t WS_WGI = WS_WRO + (size_t)1024 * 2048 * 2;
constexpr size_t WS_WGO = WS_WGI + (size_t)GLA_N * 1024 * 2;
constexpr size_t WS_WUP = WS_WGO + (size_t)1024 * 1024 * 2;
constexpr size_t WS_WDN = WS_WUP + (size_t)2 * FF2 * 1024 * 2;
constexpr size_t WS_H = WS_WDN + (size_t)2 * 1024 * FF * 2;
constexpr size_t WS_HALO = WS_H + (size_t)MT_ * DM * 2;
constexpr size_t WS_EB = WS_HALO + (size_t)2048 * 2 * FF * 2;
constexpr size_t WS_BIG = WS_EB + (size_t)NCHUNK * 512 * 4;
constexpr size_t WS_LG = WS_BIG + (size_t)MT_ * GLA_NB * 2;
constexpr size_t WS_TMP = WS_HALO;
constexpr size_t WS_SS = WS_TMP + (size_t)3 * MS * DM * 4;
constexpr size_t WS_SSP = WS_SS + (size_t)3 * MT_ * 4 + 256;
constexpr size_t WS_ACT = WS_BIG;
constexpr int NBLK = MT_ / 32;
constexpr size_t WS_HEAD = WS_BIG + (size_t)MT_ * FF * 2;
constexpr size_t WS_EDGE = WS_HEAD + (size_t)NBLK * 2 * FF2 * 2;
constexpr size_t WS_USLAB = WS_EDGE + (size_t)NBLK * 2 * FF2 * 2;
constexpr size_t WS_END = WS_BIG + (size_t)MT_ * RET_N * 2;
static_assert(WS_USLAB + (size_t)4 * MS * FF2 * 4 <= WS_END, "FFN side buffers must fit inside BIG");
static_assert(WS_SSP + (size_t)MT_ * 16 * 4 <= WS_EB, "halo slot overflow");

__device__ __forceinline__ unsigned pk(float lo, float hi) { f32x2 v = {lo, hi}; bf16v2 r = __builtin_convertvector(v, bf16v2); return __builtin_bit_cast(unsigned, r); }
__device__ __forceinline__ float bf_lo(unsigned w) { return __uint_as_float(w << 16); }
__device__ __forceinline__ float bf_hi(unsigned w) { return __uint_as_float(w & 0xffff0000u); }
__device__ __forceinline__ f32x4 bf4(u32x2 w) { return (f32x4){bf_lo(w.x), bf_hi(w.x), bf_lo(w.y), bf_hi(w.y)}; }
__device__ __forceinline__ float silu(float x) { return x * __builtin_amdgcn_rcpf(1.0f + __expf(-x)); }
__device__ __forceinline__ int tidx() { int t = threadIdx.x; asm volatile("" : "+v"(t)); return t; }
__device__ __forceinline__ int bidx() { int t = blockIdx.x; asm volatile("" : "+s"(t)); return t; }
#define MFMA16(a, b, c) __builtin_amdgcn_mfma_f32_16x16x32_bf16((a), (b), (c), 0, 0, 0)

#define XB_TMO      128
#define XB_XCNT(j)  (256  + 64 * (j))
#define XB_XSUB(j)  (1280 + 64 * (j))
#define XB_XGEN(j)  (2304 + 64 * (j))
#define XB_TOP      3328
#define XB_TOPGEN   3392
#define XCD_BAR_WORDS 3456
#define XB_SPIN_CAP (1u << 22)
__device__ __forceinline__ unsigned xb_ld(unsigned* p)              { return __hip_atomic_load(p, __ATOMIC_RELAXED, __HIP_MEMORY_SCOPE_AGENT); }
__device__ __forceinline__ unsigned xb_add(unsigned* p, unsigned v) { return __hip_atomic_fetch_add(p, v, __ATOMIC_RELAXED, __HIP_MEMORY_SCOPE_AGENT); }
__device__ __forceinline__ unsigned xb_xcc_id() { return (unsigned)__builtin_amdgcn_s_getreg((3 << 11) | 20) & 0xFu; }
#define XB_SPIN(cond, bar) do { unsigned _sp = 0; while (cond) { __builtin_amdgcn_s_sleep(1); \
    if ((++_sp & 255u) == 0u) { if (xb_ld(&(bar)[XB_TMO])) break; if (_sp > XB_SPIN_CAP) { atomicAdd(&(bar)[XB_TMO], 1u); break; } } } } while (0)
struct XcdBarrier { unsigned* bar; unsigned x; volatile LAS unsigned* st; };
__device__ __forceinline__ XcdBarrier xcd_barrier_post(unsigned* bar, volatile LAS unsigned* st) {
    XcdBarrier b; b.bar = bar; b.x = xb_xcc_id(); b.st = st;
    if (threadIdx.x == 0) (void)xb_add(&bar[XB_XCNT(b.x)], 1u);
    return b;
}
__device__ __forceinline__ void xcd_barrier_complete(unsigned* bar, unsigned x, unsigned& nloc, unsigned& nx) {
    const unsigned G = gridDim.x * gridDim.y * gridDim.z;
    unsigned sum, cnt, mine, sp = 0u;
    for (;;) {
        sum = 0u; cnt = 0u; mine = 0u;
#pragma unroll
        for (unsigned j = 0; j < 16; ++j) { const unsigned c = xb_ld(&bar[XB_XCNT(j)]); sum += c; cnt += (c > 0u) ? 1u : 0u; mine = (j == x) ? c : mine; }
        if (sum == G) break;
        __builtin_amdgcn_s_sleep(1);
        if ((++sp & 255u) == 0u) { if (xb_ld(&bar[XB_TMO])) break; if (sp > XB_SPIN_CAP) { atomicAdd(&bar[XB_TMO], 1u); break; } }
    }
    nloc = mine > 0u ? mine : 1u; nx = cnt > 0u ? cnt : 1u;
}
__device__ __forceinline__ void xcd_barrier(const XcdBarrier& b) {
    asm volatile("s_waitcnt vmcnt(0)" ::: "memory");
    __syncthreads();
    if (threadIdx.x == 0) {
        unsigned* bar = b.bar;
        __builtin_amdgcn_s_waitcnt(0);
        unsigned nloc = b.st[0], nx = b.st[1];
        if (nloc == 0u) { xcd_barrier_complete(bar, b.x, nloc, nx); b.st[0] = nloc; b.st[1] = nx; }
        const unsigned old = xb_add(&bar[XB_XSUB(b.x)], 1u);
        const unsigned gen = old / nloc;
        if (old + 1u == (gen + 1u) * nloc) {
            __builtin_amdgcn_fence(__ATOMIC_RELEASE, "agent");
            asm volatile("s_waitcnt vmcnt(0)" ::: "memory");
            const unsigned og = xb_add(&bar[XB_TOP], 1u);
            const unsigned tg = og / nx;
            if (og + 1u == (tg + 1u) * nx) xb_add(&bar[XB_TOPGEN], 1u);
            else XB_SPIN(xb_ld(&bar[XB_TOPGEN]) == tg, bar);
            __builtin_amdgcn_fence(__ATOMIC_ACQUIRE, "agent");
            xb_add(&bar[XB_XGEN(b.x)], 1u);
            asm volatile("s_waitcnt vmcnt(0)" ::: "memory");
        } else {
            XB_SPIN(xb_ld(&bar[XB_XGEN(b.x)]) == gen, bar);
            __builtin_amdgcn_fence(__ATOMIC_ACQUIRE, "agent");
            asm volatile("s_waitcnt vmcnt(0)" ::: "memory");
        }
    }
    __syncthreads();
}

struct Args {
    const float* in[20];
    float* out; unsigned char* ws;
    int ph_lo, ph_hi;
};

namespace pg8 {
constexpr int BM = 256, BK = 64, HALF = 128, HTB = HALF * BK * 2, STAGE_BYTES = 8 * HTB, NXCD = 8, WGM = 8;
__host__ __device__ __forceinline__ int lds_byte(int r, int c) { const int st = (r >> 4) * 2 + (c >> 5), rr = r & 15, cc = c & 31, ob = rr * 64 + cc * 2; return st * 1024 + (ob ^ (((ob >> 9) & 1) << 5)); }
__host__ __device__ __forceinline__ void stage_rc(int b, int& R, int& C) { const int st = b / 1024, sb = b % 1024, swz = sb ^ (((sb >> 9) & 1) << 5); R = (st >> 1) * 16 + swz / 64; C = (st & 1) * 32 + (swz % 64) / 2; }
__host__ __device__ __forceinline__ int perm32(int rho) { const int n = rho >> 4, i = rho & 15; return 8 * (i >> 2) + 4 * n + (i & 3); }
struct Unit { int pm, pn, kt0, nkt, split; };
struct Gemm { const bf16_t* A; const bf16_t* Bt; int M, N, K, lda; };
struct StaticOrder {
    int nM, nN, nwg, G, c, ntK, spl, npieces;
    __device__ __forceinline__ void init(int M, int N, int K, int G_, int c_, int spl_) { nM = M / BM; nN = N / BM; ntK = K / BK; spl = spl_; if (spl) { nM -= 1; npieces = nN * 4; } else npieces = 0; nwg = nM * nN; G = G_; c = c_; }
    __device__ __forceinline__ bool next(int i, Unit& u) const {
        const long L = (long)i * G + c;
        if (L >= nwg) { const int q = (int)(L - nwg); if (q >= npieces) return false; const int p = q / nN, half = ntK >> 1, b0 = (p * half) >> 2, b1 = ((p + 1) * half) >> 2;
            u.pm = nM; u.pn = q % nN; u.kt0 = 2 * b0; u.nkt = 2 * (b1 - b0); u.split = spl == 5 ? p + 1 : p; return true; }
        int wgid = (int)L; { const int q = nwg / NXCD, r = nwg % NXCD, xcd = wgid % NXCD, off = wgid / NXCD; wgid = (xcd < r ? xcd * (q + 1) : r * (q + 1) + (xcd - r) * q) + off; }
        const int nig = WGM * nN, gid = wgid / nig, fm = gid * WGM, gsz = (nM - fm) < WGM ? (nM - fm) : WGM;
        u.pm = fm + ((wgid % nig) % gsz); u.pn = (wgid % nig) / gsz; u.kt0 = 0; u.nkt = ntK; u.split = 0; return true;
    }
};

template <class Epi>
__device__ __forceinline__ void gemm_phase(LAS unsigned char* lds, const Gemm g, const StaticOrder& S, const Epi& E) {
    const int tid = tidx(), wid = __builtin_amdgcn_readfirstlane(tid >> 6), lane = tid & 63, wr = wid >> 2, wc = wid & 3, fr = lane & 15, fq = lane >> 4;
    const int K = g.K, lda = g.lda;
    unsigned voffA[2], voffB[2];
#pragma unroll
    for (int i = 0; i < 2; ++i) { int R, C; stage_rc(tid * 16 + i * 8192, R, C); const int Rb = (R & ~31) + perm32(R & 31);
        voffA[i] = (unsigned)(R * lda + C) * 2u; voffB[i] = (unsigned)(Rb * K + C) * 2u; }
    const size_t kstep = (size_t)(BK * 2);
    const size_t hstepA = (size_t)HALF * lda * 2, hstepB = (size_t)HALF * K * 2;
    const size_t tstepA = 2 * hstepA, tstepB = 2 * hstepB;
    const unsigned ldsw = (unsigned)wid * 1024u;
    const int aoff = lds_byte(wr * 64 + fr, fq * 8), boff = lds_byte(wc * 32 + fr, fq * 8);
#define PG8_SA(b, h) (((b) * 2 + (h)) * HTB)
#define PG8_SB(b, h) ((4 + (b) * 2 + (h)) * HTB)
#define PG8_STAGE(bufoff, gbase, voff) do { _Pragma("unroll") for (int _i = 0; _i < 2; ++_i) \
        __builtin_amdgcn_global_load_lds((const unsigned*)((const char*)(gbase) + (voff)[_i]), (LAS unsigned*)(lds + (bufoff) + ldsw + _i * 8192), 16, 0, 0); } while (0)
#define PG8_LDA(dst, b, h) do { _Pragma("unroll") for (int m = 0; m < 4; ++m) _Pragma("unroll") for (int k = 0; k < 2; ++k) dst[m][k] = *(const LAS bf16x8*)(lds + PG8_SA(b, h) + aoff + m * 2048 + k * 1024); } while (0)
#define PG8_LDB(dst, b, h) do { _Pragma("unroll") for (int n = 0; n < 2; ++n) _Pragma("unroll") for (int k = 0; k < 2; ++k) dst[n][k] = *(const LAS bf16x8*)(lds + PG8_SB(b, h) + boff + n * 2048 + k * 1024); } while (0)
#define PG8_MMA(ai, bj, At, Bt) do { __builtin_amdgcn_s_setprio(1); _Pragma("unroll") for (int m = 0; m < 4; ++m) _Pragma("unroll") for (int n = 0; n < 2; ++n) _Pragma("unroll") for (int k = 0; k < 2; ++k) \
        acc[ai][bj][m][n] = __builtin_amdgcn_mfma_f32_16x16x32_bf16(Bt[n][k], At[m][k], acc[ai][bj][m][n], 0, 0, 0); __builtin_amdgcn_s_setprio(0); } while (0)
#define PG8_WAIT_V(n) asm volatile("s_waitcnt vmcnt(" #n ")" ::: "memory")
#define PG8_WAIT_L(n) asm volatile("s_waitcnt lgkmcnt(" #n ")" ::: "memory")
#define PG8_BAR __builtin_amdgcn_s_barrier()
#define PG8_SCHED __builtin_amdgcn_sched_barrier(0)
    Unit cur, nxt; int ui = 0;
    if (!S.next(0, cur)) return;
    f32x4 acc[2][2][4][2];
#pragma unroll
    for (int a = 0; a < 2; ++a)
#pragma unroll
        for (int b = 0; b < 2; ++b)
#pragma unroll
            for (int m = 0; m < 4; ++m)
#pragma unroll
                for (int n = 0; n < 2; ++n) acc[a][b][m][n] = (f32x4){0.f, 0.f, 0.f, 0.f};
    bf16x8 At[4][2], B0[2][2], B1[2][2];
    const char* cA = (const char*)g.A + (size_t)cur.pm * tstepA + (size_t)cur.kt0 * kstep; const char* cB = (const char*)g.Bt + (size_t)cur.pn * tstepB + (size_t)cur.kt0 * kstep;
    if constexpr (Epi::LOOKAHEAD) E.fetch(lds, cur.pn, cur.pm, 0, wid, lane);
    PG8_STAGE(PG8_SB(0, 0), cB, voffB); PG8_STAGE(PG8_SA(0, 0), cA, voffA); PG8_STAGE(PG8_SB(0, 1), cB + hstepB, voffB); PG8_STAGE(PG8_SA(0, 1), cA + hstepA, voffA);
    if (wr == 1) PG8_BAR;
    PG8_WAIT_V(4); PG8_BAR;
    PG8_STAGE(PG8_SB(1, 0), cB + kstep, voffB); PG8_STAGE(PG8_SA(1, 0), cA + kstep, voffA); PG8_STAGE(PG8_SB(1, 1), cB + hstepB + kstep, voffB);
    PG8_WAIT_V(6); PG8_BAR;
    for (;;) {
        const bool has_next = S.next(ui + 1, nxt);
        const char* nA = has_next ? (const char*)g.A + (size_t)nxt.pm * tstepA + (size_t)nxt.kt0 * kstep : cA; const char* nB = has_next ? (const char*)g.Bt + (size_t)nxt.pn * tstepB + (size_t)nxt.kt0 * kstep : cB;
        const int nt = cur.nkt;
        for (int t = 0; t < nt; t += 2) {
            const bool last = (t == nt - 2);
            const char* a1 = cA + (size_t)(t + 1) * kstep;
            const char* a2 = last ? nA : cA + (size_t)(t + 2) * kstep; const char* b2 = last ? nB : cB + (size_t)(t + 2) * kstep;
            const char* a3 = a2 + kstep; const char* b3 = b2 + kstep;
            PG8_LDB(B0, 0, 0); PG8_SCHED; PG8_LDA(At, 0, 0); PG8_STAGE(PG8_SA(1, 1), a1 + hstepA, voffA);
            PG8_WAIT_L(8); PG8_BAR; PG8_WAIT_L(0); PG8_MMA(0, 0, At, B0); PG8_BAR; PG8_SCHED;
            PG8_LDB(B1, 0, 1); PG8_STAGE(PG8_SB(0, 0), b2, voffB);
            PG8_BAR; PG8_WAIT_L(0); PG8_MMA(0, 1, At, B1); PG8_BAR;
            PG8_LDA(At, 0, 1); PG8_STAGE(PG8_SA(0, 0), a2, voffA);
            PG8_BAR; PG8_WAIT_L(0); PG8_MMA(1, 0, At, B0); PG8_BAR; PG8_SCHED;
            PG8_STAGE(PG8_SB(0, 1), b2 + hstepB, voffB);
            PG8_WAIT_V(6); PG8_BAR; PG8_MMA(1, 1, At, B1); PG8_BAR;
            PG8_LDB(B0, 1, 0); PG8_SCHED; PG8_LDA(At, 1, 0); PG8_STAGE(PG8_SA(0, 1), a2 + hstepA, voffA);
            PG8_WAIT_L(8); PG8_BAR; PG8_WAIT_L(0); PG8_MMA(0, 0, At, B0); PG8_BAR; PG8_SCHED;
            PG8_LDB(B1, 1, 1); PG8_STAGE(PG8_SB(1, 0), b3, voffB);
            PG8_BAR; PG8_WAIT_L(0); PG8_MMA(0, 1, At, B1); PG8_BAR;
            PG8_LDA(At, 1, 1); PG8_STAGE(PG8_SA(1, 0), a3, voffA);
            PG8_BAR; PG8_WAIT_L(0); PG8_MMA(1, 0, At, B0); PG8_BAR; PG8_SCHED;
            PG8_STAGE(PG8_SB(1, 1), b3 + hstepB, voffB);
            PG8_WAIT_V(6); PG8_BAR; PG8_MMA(1, 1, At, B1); PG8_BAR;
        }
        if constexpr (Epi::LOOKAHEAD) E.ep(acc, cur, (has_next && nxt.split == 0) ? nxt.pn : -1, has_next ? nxt.pm : 0, ui, lds, wr, wc, fr, fq); else E(acc, cur, wr, wc, fr, fq);
        if (!has_next) break;
#pragma unroll
        for (int a = 0; a < 2; ++a)
#pragma unroll
            for (int b = 0; b < 2; ++b)
#pragma unroll
                for (int m = 0; m < 4; ++m)
#pragma unroll
                    for (int n = 0; n < 2; ++n) acc[a][b][m][n] = (f32x4){0.f, 0.f, 0.f, 0.f};
        cur = nxt; cA = nA; cB = nB; ++ui;
    }
    PG8_WAIT_V(0);
    if (wr == 0) PG8_BAR;
    PG8_BAR;
#undef PG8_SA
#undef PG8_SB
#undef PG8_STAGE
#undef PG8_LDA
#undef PG8_LDB
#undef PG8_MMA
#undef PG8_WAIT_V
#undef PG8_WAIT_L
#undef PG8_BAR
#undef PG8_SCHED
}
}

template <int MODE> struct Epi {
    static constexpr bool LOOKAHEAD = (MODE == 3);
    __device__ __forceinline__ void fetch(LAS unsigned char* lds, int pn, int pm, int slot, int wv_, int ln_) const {
        if (wv_ < 4) __builtin_amdgcn_global_load_lds((const unsigned*)(ssr + 256 * pm + wv_ * 64 + ln_), (LAS unsigned*)((LAS float*)(lds + 131072) + (slot & 1) * 1280 + 1024 + wv_ * 64), 4, 0, 0);
    }
    __device__ __forceinline__ void ep(const f32x4 (&acc)[2][2][4][2], const pg8::Unit& u, int npn, int npm, int ui, LAS unsigned char* lds, int wr, int wc, int fr, int fq) const {
        if (npn >= 0) fetch(lds, npn, npm, ui + 1, wr * 4 + wc, (fq << 4) + fr);
        body(acc, u, wr, wc, fr, fq, (const LAS float*)(lds + 131072) + (ui & 1) * 1280 + 1024);
    }
    __device__ __forceinline__ void operator()(const f32x4 (&acc)[2][2][4][2], const pg8::Unit& u, int wr, int wc, int fr, int fq) const { body(acc, u, wr, wc, fr, fq, nullptr); }
    bf16_t* O; int ldc;
    const f32x2* rot;
    const float* resP; const float* resS; float* tmp;
    bf16_t* lg; const float* b_a;
    bf16_t* xb; float* ssw;
    const float* ssr;
    __device__ __forceinline__ void body(const f32x4 (&acc)[2][2][4][2], const pg8::Unit& u, int wr, int wc, int fr, int fq, const LAS float* sl) const {
        const int row0 = u.pm * 256 + wr * 64 + fr;
        const int colt = u.pn * 256 + wc * 32 + 8 * fq;
        if (MODE == 1 && u.pn < 8) {
            const int hh = u.pn & 3; const bool isq = u.pn < 4;
            const float lgam = hh == 0 ? -0.031748698314580f : hh == 1 ? -0.015748356968139f : hh == 2 ? -0.007843177461025f : -0.003913899321136f;
            const int d0 = wc * 32 + 8 * fq;
#pragma unroll
            for (int ai = 0; ai < 2; ++ai)
#pragma unroll
                for (int m = 0; m < 4; ++m) {
                    const int r = row0 + ai * 128 + m * 16;
                    int pos, ci;
                    if (r < MP) { pos = r & (SEQ - 1); ci = pos & 63; } else { const int t = (r - MP) & (DSEQ - 1); pos = PAST + t; ci = t; }
                    const float e = (float)(ci + 1) * lgam; const float f = __expf(isq ? e : -e);
                    const f32x4* tp = (const f32x4*)(rot + (size_t)pos * 128 + d0);
                    const f32x4 t0 = tp[0], t1 = tp[1], t2 = tp[2], t3 = tp[3];
                    const f32x4 a0 = acc[ai][0][m][0], a1 = acc[ai][0][m][1], b0 = acc[ai][1][m][0], b1 = acc[ai][1][m][1];
                    f32x4 y0, y1, z0, z1;
                    y0[0] = (a0[0] * t0[0] - b0[0] * t0[1]) * f; z0[0] = (a0[0] * t0[1] + b0[0] * t0[0]) * f;
                    y0[1] = (a0[1] * t0[2] - b0[1] * t0[3]) * f; z0[1] = (a0[1] * t0[3] + b0[1] * t0[2]) * f;
                    y0[2] = (a0[2] * t1[0] - b0[2] * t1[1]) * f; z0[2] = (a0[2] * t1[1] + b0[2] * t1[0]) * f;
                    y0[3] = (a0[3] * t1[2] - b0[3] * t1[3]) * f; z0[3] = (a0[3] * t1[3] + b0[3] * t1[2]) * f;
                    y1[0] = (a1[0] * t2[0] - b1[0] * t2[1]) * f; z1[0] = (a1[0] * t2[1] + b1[0] * t2[0]) * f;
                    y1[1] = (a1[1] * t2[2] - b1[1] * t2[3]) * f; z1[1] = (a1[1] * t2[3] + b1[1] * t2[2]) * f;
                    y1[2] = (a1[2] * t3[0] - b1[2] * t3[1]) * f; z1[2] = (a1[2] * t3[1] + b1[2] * t3[0]) * f;
                    y1[3] = (a1[3] * t3[2] - b1[3] * t3[3]) * f; z1[3] = (a1[3] * t3[3] + b1[3] * t3[2]) * f;
                    bf16_t* rowp = O + (size_t)r * ldc + colt;
                    u32x4 w; w.x = pk(y0[0], y0[1]); w.y = pk(y0[2], y0[3]); w.z = pk(y1[0], y1[1]); w.w = pk(y1[2], y1[3]);
                    *(u32x4*)(rowp) = w;
                    w.x = pk(z0[0], z0[1]); w.y = pk(z0[2], z0[3]); w.z = pk(z1[0], z1[1]); w.w = pk(z1[2], z1[3]);
                    *(u32x4*)(rowp + 128) = w;
                }
            return;
        }
        if (MODE == 3 && u.pn >= 12) {
            if (wc == 0 && fq < 2) {
#pragma unroll
                for (int ai = 0; ai < 2; ++ai)
#pragma unroll
                    for (int m = 0; m < 4; ++m) {
                        const int r = row0 + ai * 128 + m * 16;
                        const float rs = rsqrtf(sl[r - u.pm * 256] * (1.0f / DM) + EPS);
                        const f32x4 v0 = acc[ai][0][m][0] * rs, v1 = acc[ai][0][m][1] * rs;
                        u32x4 w; w.x = pk(v0[0], v0[1]); w.y = pk(v0[2], v0[3]); w.z = pk(v1[0], v1[1]); w.w = pk(v1[2], v1[3]);
                        *(u32x4*)(lg + (size_t)r * 16 + 8 * fq) = w;
                    }
            }
            return;
        }
        if (MODE == 2) {
#pragma unroll
            for (int ai = 0; ai < 2; ++ai)
#pragma unroll
                for (int m = 0; m < 4; ++m) {
                    const int r = row0 + ai * 128 + m * 16;
                    if (u.split) {
                        float* tp = tmp + ((size_t)(u.split - 1) * MS + (r - MP)) * DM + colt;
#pragma unroll
                        for (int bj = 0; bj < 2; ++bj)
#pragma unroll
                            for (int n = 0; n < 2; ++n) *(f32x4*)(tp + bj * 128 + 4 * n) = acc[ai][bj][m][n];
                        continue;
                    }
                    bf16_t* xp = xb + (size_t)r * DM + colt;
                    const float* rp = resP ? (r < MP ? resP + (size_t)r * DM : resS + (size_t)(r - MP) * DM) + colt : nullptr;
                    float sq = 0.f; const bool stat = ssw != nullptr && r < MP;
#pragma unroll
                    for (int bj = 0; bj < 2; ++bj) {
                        f32x4 r0, r1;
                        if (resP) { r0 = *(const f32x4*)(rp + bj * 128); r1 = *(const f32x4*)(rp + bj * 128 + 4); }
                        else { const u32x4 w = *(const u32x4*)(xp + bj * 128); r0 = (f32x4){bf_lo(w.x), bf_hi(w.x), bf_lo(w.y), bf_hi(w.y)}; r1 = (f32x4){bf_lo(w.z), bf_hi(w.z), bf_lo(w.w), bf_hi(w.w)}; }
                        const f32x4 v0 = r0 + acc[ai][bj][m][0], v1 = r1 + acc[ai][bj][m][1];
                        u32x4 w; w.x = pk(v0[0], v0[1]); w.y = pk(v0[2], v0[3]); w.z = pk(v1[0], v1[1]); w.w = pk(v1[2], v1[3]); *(u32x4*)(xp + bj * 128) = w;
                        if (stat) sq += (v0[0] * v0[0] + v0[1] * v0[1]) + (v0[2] * v0[2] + v0[3] * v0[3]) + (v1[0] * v1[0] + v1[1] * v1[1]) + (v1[2] * v1[2] + v1[3] * v1[3]);
                    }
                    if (stat) { sq += __shfl_xor(sq, 16); sq += __shfl_xor(sq, 32); if (fq == 0) ssw[(size_t)r * 16 + u.pn * 4 + wc] = sq; }
                }
            return;
        }
#pragma unroll
        for (int ai = 0; ai < 2; ++ai)
#pragma unroll
            for (int m = 0; m < 4; ++m) {
                bf16_t* rowp = O + (size_t)(row0 + ai * 128 + m * 16) * ldc + colt;
                const float rs = MODE == 3 ? rsqrtf(sl[wr * 64 + fr + ai * 128 + m * 16] * (1.0f / DM) + EPS) : 1.0f;
#pragma unroll
                for (int bj = 0; bj < 2; ++bj) {
                    const f32x4 v0 = acc[ai][bj][m][0] * rs, v1 = acc[ai][bj][m][1] * rs;
                    u32x4 w; w.x = pk(v0[0], v0[1]); w.y = pk(v0[2], v0[3]); w.z = pk(v1[0], v1[1]); w.w = pk(v1[2], v1[3]);
                    *(u32x4*)(rowp + bj * 128) = w;
                }
            }
    }
};


template <int CTRL> __device__ __forceinline__ float dpp_keep(float old, float x) { return __builtin_bit_cast(float, __builtin_amdgcn_update_dpp(__builtin_bit_cast(int, old), __builtin_bit_cast(int, x), CTRL, 0xf, 0xf, false)); }
template <int CTRL> __device__ __forceinline__ float dpp_zero(float x) { return __builtin_bit_cast(float, __builtin_amdgcn_update_dpp(0, __builtin_bit_cast(int, x), CTRL, 0xf, 0xf, true)); }
struct EpiConv {
    bf16_t* act; bf16_t* head; bf16_t* edge; const float* cw; const float* cb; float* uslab; const float* ss;
    static constexpr bool LOOKAHEAD = true;
    __device__ __forceinline__ void fetch(LAS unsigned char* lds, int pn, int pm, int slot, int wv_, int ln_) const {
        if (wv_ < 4) __builtin_amdgcn_global_load_lds((const unsigned*)(ss + 256 * pm + wv_ * 64 + ln_), (LAS unsigned*)((LAS float*)(lds + 131072) + (slot & 1) * 1280 + 1024 + wv_ * 64), 4, 0, 0);
#pragma unroll
        for (int hh = 0; hh < 2; ++hh) { const int e = hh * 512 + wv_ * 64 + ln_, prm = e >> 8, typ = (e >> 7) & 1, col = e & 127;
            __builtin_amdgcn_global_load_lds((const unsigned*)((prm < 3 ? cw + prm * FF2 : cb) + typ * FF + 128 * pn + col),
                                             (LAS unsigned*)((LAS float*)(lds + 131072) + (slot & 1) * 1280 + hh * 512 + wv_ * 64), 4, 0, 0); }
    }
    __device__ __forceinline__ void ep(const f32x4 (&acc)[2][2][4][2], const pg8::Unit& u, int npn, int npm, int ui, LAS unsigned char* lds, int wr, int wc, int fr, int fq) const {
        const int f0 = u.pn * 128 + wc * 32 + 8 * fq;
        LAS float* WLc = (LAS float*)(lds + 131072) + (ui & 1) * 1280;
        const bool donext = npn >= 0;
        if (donext && !u.split) fetch(lds, npn, npm, ui + 1, wr * 4 + wc, (fq << 4) + fr);
        const int fl = wc * 32 + 8 * fq;
        if (u.split) {
            float* sp = uslab + (size_t)(u.split - 1) * MS * FF2 + f0;
#pragma unroll
            for (int ai = 0; ai < 2; ++ai)
#pragma unroll
                for (int m = 0; m < 4; ++m) { float* rp = sp + (size_t)(ai * 128 + wr * 64 + m * 16 + fr) * FF2;
#pragma unroll
                    for (int n = 0; n < 2; ++n) { *(f32x4*)(rp + 4 * n) = acc[ai][0][m][n]; *(f32x4*)(rp + FF + 4 * n) = acc[ai][1][m][n]; } }
            return;
        }
#pragma unroll
        for (int n = 0; n < 2; ++n) {
            const int f = f0 + 4 * n;
#pragma unroll
            for (int ai = 0; ai < 2; ++ai)
#pragma unroll
                for (int mh = 0; mh < 2; ++mh) {
                    const int rowb = u.pm * 256 + ai * 128 + wr * 64 + mh * 32, blk = rowb >> 5;
                    f32x4 wg0, wg1, wg2, bg, wv0, wv1, wv2, bv;
                    { const LAS float* wl = WLc + fl + 4 * n;
                        wg0 = *(const LAS f32x4*)wl; wv0 = *(const LAS f32x4*)(wl + 128); wg1 = *(const LAS f32x4*)(wl + 256); wv1 = *(const LAS f32x4*)(wl + 384);
                        wg2 = *(const LAS f32x4*)(wl + 512); wv2 = *(const LAS f32x4*)(wl + 640); bg = *(const LAS f32x4*)(wl + 768); bv = *(const LAS f32x4*)(wl + 896); }
                    const int rl = ai * 128 + wr * 64 + mh * 32 + fr;
                    const float s0 = WLc[1024 + rl], s1 = WLc[1024 + rl + 16];
                    const float rs0 = rsqrtf(s0 * (1.0f / DM) + EPS), rs1 = rsqrtf(s1 * (1.0f / DM) + EPS);
                    const f32x4 xg0 = acc[ai][0][2 * mh][n] * rs0, xg1 = acc[ai][0][2 * mh + 1][n] * rs1, xv0 = acc[ai][1][2 * mh][n] * rs0, xv1 = acc[ai][1][2 * mh + 1][n] * rs1;
                    if (fr < 2 || fr >= 14) {
                        const bool isH = fr < 2;
                        const f32x4 sg = isH ? xg0 : xg1, sv = isH ? xv0 : xv1;
                        bf16_t* bp = (isH ? head : edge) + ((unsigned)(blk * 2 + (isH ? fr : fr - 14)) * (unsigned)FF2 + (unsigned)f);
                        u32x2 w; w.x = pk(sg[0], sg[1]); w.y = pk(sg[2], sg[3]); *(u32x2*)bp = w; w.x = pk(sv[0], sv[1]); w.y = pk(sv[2], sv[3]); *(u32x2*)(bp + FF) = w; }
                    f32x4 a0, a1;
#pragma unroll
                    for (int j = 0; j < 4; ++j) {
                        const float g1 = dpp_zero<0x111>(xg0[j]), g2 = dpp_zero<0x112>(xg0[j]), v1 = dpp_zero<0x111>(xv0[j]), v2 = dpp_zero<0x112>(xv0[j]);
                        const float cg = bg[j] + g2 * wg0[j] + g1 * wg1[j] + xg0[j] * wg2[j], cv = bv[j] + v2 * wv0[j] + v1 * wv1[j] + xv0[j] * wv2[j];
                        a0[j] = silu(cg) * cv;
                        const float h1 = dpp_keep<0x111>(dpp_zero<0x10F>(xg0[j]), xg1[j]), h2 = dpp_keep<0x112>(dpp_zero<0x10E>(xg0[j]), xg1[j]);
                        const float w1 = dpp_keep<0x111>(dpp_zero<0x10F>(xv0[j]), xv1[j]), w2 = dpp_keep<0x112>(dpp_zero<0x10E>(xv0[j]), xv1[j]);
                        const float dg = bg[j] + h2 * wg0[j] + h1 * wg1[j] + xg1[j] * wg2[j], dv = bv[j] + w2 * wv0[j] + w1 * wv1[j] + xv1[j] * wv2[j];
                        a1[j] = silu(dg) * dv;

                    }
                    u32x2 w;
                    if (fr >= 2) { w.x = pk(a0[0], a0[1]); w.y = pk(a0[2], a0[3]); *(u32x2*)(act + (size_t)(rowb + fr) * FF + f) = w; }
                    w.x = pk(a1[0], a1[1]); w.y = pk(a1[2], a1[3]); *(u32x2*)(act + (size_t)(rowb + 16 + fr) * FF + f) = w;
                    __builtin_amdgcn_sched_barrier(0);
                }
        }
    }
};
__device__ __forceinline__ void convfix_phase(bf16_t* act, const bf16_t* head, const bf16_t* edge, const float* cw, const float* cb, const float* cache, float* convP, float* convS, const float* uslab, const float* ss) {
    const int gtid = bidx() * 512 + tidx(), gthreads = gridDim.x * 512;
    for (int i = gtid; i < (MP / 32) * 2 * (FF / 4); i += gthreads) {
        const int c = 4 * (i % (FF / 4)), jj = (i / (FF / 4)) & 1, B = i / (2 * (FF / 4));
        const bool samp = B >= MP / 32, first = samp || (B & 255) == 0;
        const f32x4 wg0 = *(const f32x4*)(cw + c), wg1 = *(const f32x4*)(cw + FF2 + c), wg2 = *(const f32x4*)(cw + 2 * FF2 + c), bg = *(const f32x4*)(cb + c);
        const f32x4 wv0 = *(const f32x4*)(cw + FF + c), wv1 = *(const f32x4*)(cw + FF2 + FF + c), wv2 = *(const f32x4*)(cw + 2 * FF2 + FF + c), bv = *(const f32x4*)(cb + FF + c);
        const bf16_t* hp = head + ((size_t)B * 2 + jj) * FF2 + c;
        const f32x4 xg = bf4(*(const u32x2*)hp), xv = bf4(*(const u32x2*)(hp + FF));
        f32x4 e0g, e0v, e1g, e1v;
        if (!first) { const bf16_t* ep = edge + ((size_t)(B - 1) * 2) * FF2 + c; e0g = bf4(*(const u32x2*)ep); e0v = bf4(*(const u32x2*)(ep + FF)); e1g = bf4(*(const u32x2*)(ep + FF2)); e1v = bf4(*(const u32x2*)(ep + FF2 + FF)); }
        else if (samp) { const float* cs = cache + (size_t)(B - MP / 32) * 2 * FF2 + c; e0g = *(const f32x4*)cs; e0v = *(const f32x4*)(cs + FF); e1g = *(const f32x4*)(cs + FF2); e1v = *(const f32x4*)(cs + FF2 + FF); }
        else { e0g = e0v = e1g = e1v = (f32x4){0.f, 0.f, 0.f, 0.f}; }
        f32x4 p2g, p2v, p1g, p1v;
        if (jj == 0) { p2g = e0g; p2v = e0v; p1g = e1g; p1v = e1v; }
        else { p2g = e1g; p2v = e1v; const bf16_t* h0 = head + ((size_t)B * 2) * FF2 + c; p1g = bf4(*(const u32x2*)h0); p1v = bf4(*(const u32x2*)(h0 + FF)); }
        const f32x4 cg = bg + p2g * wg0 + p1g * wg1 + xg * wg2, cv = bv + p2v * wv0 + p1v * wv1 + xv * wv2;
        u32x2 w; w.x = pk(silu(cg[0]) * cv[0], silu(cg[1]) * cv[1]); w.y = pk(silu(cg[2]) * cv[2], silu(cg[3]) * cv[3]);
        *(u32x2*)(act + (size_t)(32 * B + jj) * FF + c) = w;
    }
    for (int i = gtid; i < MS * (FF / 4); i += gthreads) {
        const int c = 4 * (i % (FF / 4)), r = i / (FF / 4), t = r & 31, b = r >> 5;
        const f32x4 wg0 = *(const f32x4*)(cw + c), wg1 = *(const f32x4*)(cw + FF2 + c), wg2 = *(const f32x4*)(cw + 2 * FF2 + c), bg = *(const f32x4*)(cb + c);
        const f32x4 wv0 = *(const f32x4*)(cw + FF + c), wv1 = *(const f32x4*)(cw + FF2 + FF + c), wv2 = *(const f32x4*)(cw + 2 * FF2 + FF + c), bv = *(const f32x4*)(cb + FF + c);
        f32x4 xg[3], xv[3];
#pragma unroll
        for (int k = 0; k < 3; ++k) { const int tt = t - 2 + k;
            if (tt < 0) { const float* cs = cache + ((size_t)b * 2 + (tt + 2)) * FF2 + c; xg[k] = *(const f32x4*)cs; xv[k] = *(const f32x4*)(cs + FF); }
            else { const float* sp = uslab + (size_t)(r - 2 + k) * FF2 + c; xg[k] = (f32x4){0.f, 0.f, 0.f, 0.f}; xv[k] = xg[k];
#pragma unroll
                for (int p4 = 0; p4 < 4; ++p4) { xg[k] += *(const f32x4*)(sp + (size_t)p4 * MS * FF2); xv[k] += *(const f32x4*)(sp + (size_t)p4 * MS * FF2 + FF); }
                const float rs = rsqrtf(ss[MP + r - 2 + k] * (1.0f / DM) + EPS); xg[k] *= rs; xv[k] *= rs; } }
        const f32x4 cg = bg + xg[0] * wg0 + xg[1] * wg1 + xg[2] * wg2, cv = bv + xv[0] * wv0 + xv[1] * wv1 + xv[2] * wv2;
        u32x2 w; w.x = pk(silu(cg[0]) * cv[0], silu(cg[1]) * cv[1]); w.y = pk(silu(cg[2]) * cv[2], silu(cg[3]) * cv[3]);
        *(u32x2*)(act + (size_t)(MP + r) * FF + c) = w;
        if (t >= 30) { float* dst = convS + ((size_t)b * 2 + (t - 30)) * FF2 + c; *(f32x4*)dst = xg[2]; *(f32x4*)(dst + FF) = xv[2]; }
    }
    for (int i = gtid; i < 8 * 2 * (FF2 / 4); i += gthreads) {
        const int c = 4 * (i % (FF2 / 4)), jj = (i / (FF2 / 4)) & 1, sq = i / (2 * (FF2 / 4));
        const int B = sq * 256 + 255;
        *(f32x4*)(convP + ((size_t)sq * 2 + jj) * FF2 + c) = bf4(*(const u32x2*)(edge + ((size_t)B * 2 + jj) * FF2 + c));
    }
}

__device__ __forceinline__ void norm_phase(const float* xP, float* xS, const float* g, bf16_t* h, const float* tmp) {
    const int tid_ = tidx(), lane = tid_ & 63, wv = bidx() * 8 + (tid_ >> 6), nw = gridDim.x * 8;
    f32x4 gv[4];
#pragma unroll
    for (int i = 0; i < 4; ++i) gv[i] = *(const f32x4*)(g + (i * 64 + lane) * 4);
    for (int r0 = wv; r0 < MT_; r0 += 4 * nw) {
        f32x4 v[4][4];
#pragma unroll
        for (int u = 0; u < 4; ++u) { const int r = r0 + u * nw; if (r < MT_) { const float* xp = r < MP ? xP + (size_t)r * DM : xS + (size_t)(r - MP) * DM;
#pragma unroll
            for (int i = 0; i < 4; ++i) v[u][i] = *(const f32x4*)(xp + (i * 64 + lane) * 4);
            if (tmp && r >= MP) {
#pragma unroll
                for (int i = 0; i < 4; ++i) { const float* tp = tmp + (size_t)(r - MP) * DM + (i * 64 + lane) * 4;
                    v[u][i] += *(const f32x4*)tp + *(const f32x4*)(tp + (size_t)MS * DM) + *(const f32x4*)(tp + 2 * (size_t)MS * DM);
                    *(f32x4*)(xS + (size_t)(r - MP) * DM + (i * 64 + lane) * 4) = v[u][i]; } } } }
#pragma unroll
        for (int u = 0; u < 4; ++u) { const int r = r0 + u * nw; if (r < MT_) {
            float ss = 0.f;
#pragma unroll
            for (int i = 0; i < 4; ++i) ss += v[u][i][0] * v[u][i][0] + v[u][i][1] * v[u][i][1] + v[u][i][2] * v[u][i][2] + v[u][i][3] * v[u][i][3];
#pragma unroll
            for (int o = 32; o >= 1; o >>= 1) ss += __shfl_xor(ss, o);
            const float rs = rsqrtf(ss * (1.0f / DM) + EPS);
#pragma unroll
            for (int i = 0; i < 4; ++i) { u32x2 w; w.x = pk(v[u][i][0] * rs * gv[i][0], v[u][i][1] * rs * gv[i][1]); w.y = pk(v[u][i][2] * rs * gv[i][2], v[u][i][3] * rs * gv[i][3]);
                *(u32x2*)(h + (size_t)r * DM + (i * 64 + lane) * 4) = w; } } }
    }
}
__device__ __forceinline__ void samplenorm_phase(bf16_t* xS, float* ssS, const float* tmp, const float* ssp) {
    const int tid_ = tidx(), lane = tid_ & 63, wv = bidx() * 8 + (tid_ >> 6), nw = gridDim.x * 8;
    { const int gtid = bidx() * 512 + tid_, gthreads = gridDim.x * 512;
      for (int r = gtid; r < MP; r += gthreads) { const f32x4* pp = (const f32x4*)(ssp + (size_t)r * 16); const f32x4 a = pp[0], b = pp[1], c = pp[2], d = pp[3];
          (ssS - MP)[r] = ((a[0] + a[1]) + (a[2] + a[3])) + ((b[0] + b[1]) + (b[2] + b[3])) + ((c[0] + c[1]) + (c[2] + c[3])) + ((d[0] + d[1]) + (d[2] + d[3])); } }
    for (int r = wv; r < MS; r += nw) {
        float ss = 0.f;
#pragma unroll
        for (int i = 0; i < 4; ++i) { const size_t o = (size_t)r * DM + (i * 64 + lane) * 4; const float* tp = tmp + o;
            const f32x4 v = bf4(*(const u32x2*)(xS + o)) + *(const f32x4*)tp + *(const f32x4*)(tp + (size_t)MS * DM) + *(const f32x4*)(tp + 2 * (size_t)MS * DM);
            u32x2 w; w.x = pk(v[0], v[1]); w.y = pk(v[2], v[3]); *(u32x2*)(xS + o) = w;
            ss += (v[0] * v[0] + v[1] * v[1]) + (v[2] * v[2] + v[3] * v[3]); }
#pragma unroll
        for (int o = 32; o >= 1; o >>= 1) ss += __shfl_xor(ss, o);
        if (lane == 0) ssS[r] = ss;
    }
}
__device__ __forceinline__ void final_norm_phase(const bf16_t* xb, float* y, const float* g, int dry, const float* tmp) {
    const int tid_ = tidx(), lane = tid_ & 63, wv = bidx() * 8 + (tid_ >> 6), nw = gridDim.x * 8;
    f32x4 gv[4];
#pragma unroll
    for (int i = 0; i < 4; ++i) gv[i] = *(const f32x4*)(g + (i * 64 + lane) * 4);
    for (int r0 = wv; r0 < MT_; r0 += 4 * nw) {
        f32x4 v[4][4];
#pragma unroll
        for (int u = 0; u < 4; ++u) { const int r = r0 + u * nw; if (r < MT_) {
#pragma unroll
            for (int i = 0; i < 4; ++i) v[u][i] = bf4(*(const u32x2*)(xb + (size_t)r * DM + (i * 64 + lane) * 4));
            if (r >= MP) {
#pragma unroll
                for (int i = 0; i < 4; ++i) { const float* tp = tmp + (size_t)(r - MP) * DM + (i * 64 + lane) * 4;
                    v[u][i] += *(const f32x4*)tp + *(const f32x4*)(tp + (size_t)MS * DM) + *(const f32x4*)(tp + 2 * (size_t)MS * DM); } } } }
#pragma unroll
        for (int u = 0; u < 4; ++u) { const int r = r0 + u * nw; if (r < MT_) {
            float ss = 0.f;
#pragma unroll
            for (int i = 0; i < 4; ++i) ss += v[u][i][0] * v[u][i][0] + v[u][i][1] * v[u][i][1] + v[u][i][2] * v[u][i][2] + v[u][i][3] * v[u][i][3];
#pragma unroll
            for (int o = 32; o >= 1; o >>= 1) ss += __shfl_xor(ss, o);
            const float rs = rsqrtf(ss * (1.0f / DM) + EPS);
#pragma unroll
            for (int i = 0; i < 4; ++i) { const f32x4 yy = v[u][i] * rs * gv[i]; if (!dry) *(f32x4*)(y + (size_t)r * DM + (i * 64 + lane) * 4) = yy; } } }
    }
}

__device__ __forceinline__ void transpose_quad(LAS float* tile, const float* src, int ldsrc, int sc0, int sc1, int sc2, int sc3, bf16_t* dst, int K, int dstrow0, int tk, float scale, const float* gk = nullptr, int collim = 1 << 30) {
    const int tid_ = tidx(), tx = tid_ & 63, ty = tid_ >> 6;
    const int scol[4] = {sc0, sc1, sc2, sc3};
    float v[4][8];
#pragma unroll
    for (int sub = 0; sub < 4; ++sub)
#pragma unroll
        for (int i = 0; i < 8; ++i) v[sub][i] = (scol[sub] + tx < collim) ? src[(size_t)(tk * 64 + ty + 8 * i) * ldsrc + scol[sub] + tx] * (gk ? gk[tk * 64 + ty + 8 * i] : 1.0f) : 0.f;
#pragma unroll
    for (int sub = 0; sub < 4; ++sub)
#pragma unroll
        for (int i = 0; i < 8; ++i) tile[sub * 4160 + (ty + 8 * i) * 65 + tx] = v[sub][i];
    __syncthreads();
#pragma unroll
    for (int sub = 0; sub < 4; ++sub)
#pragma unroll
        for (int i = 0; i < 8; ++i) { const int nn = ty + 8 * i; dst[(size_t)(dstrow0 + 64 * sub + nn) * K + tk * 64 + tx] = (bf16_t)(pk(tile[sub * 4160 + tx * 65 + nn] * scale, 0.f) & 0xffffu); }
    __syncthreads();
}

__device__ __forceinline__ void weight_jobs(LAS unsigned char* lds, const Args& a, int set, int w, int nw) {
    unsigned char* ws = a.ws;
    LAS float* tile = (LAS float*)lds;
    const float* ret_w_in = a.in[8]; const float* ret_w_out = a.in[10]; const float* gla_w_in = a.in[11];
    const float* gla_w_out = a.in[15]; const float* ffn_w_up = a.in[16]; const float* ffn_w_down = a.in[19];
    const int T0 = 24 * 16, T1 = T0 + 4 * 32, T2 = T1 + 13 * 16, T3 = T2 + 4 * 16, T4 = T3 + 2 * 22 * 16, T5 = T4 + 2 * 4 * 44;
    const int U0 = T3 + 22 * 16, D0 = T4 + 4 * 44;
    const int njobs = set == 0 ? T0 : set == 1 ? (U0 - T0) + (D0 - T4) : (T4 - U0) + (T5 - D0);
    for (int jj = w; jj < njobs; jj += nw) {
        const int t = set == 0 ? jj : set == 1 ? (jj < U0 - T0 ? T0 + jj : T4 + (jj - (U0 - T0))) : (jj < T4 - U0 ? U0 + jj : D0 + (jj - (T4 - U0)));
        if (t < T0) { const int tq = t / 16, tk = t % 16, c = tq * 256; const float sc = (tq >= 4 && tq < 8) ? 0.0625f : 1.0f;
            transpose_quad(tile, ret_w_in, RET_N, c, c + 64, c + 128, c + 192, (bf16_t*)(ws + WS_WRI), 1024, c, tk, sc); }
        else if (t < T1) { const int q = t - T0, tq = q / 32, tk = q % 32, c = tq * 256; transpose_quad(tile, ret_w_out, 1024, c, c + 64, c + 128, c + 192, (bf16_t*)(ws + WS_WRO), 2048, c, tk, 1.0f); }
        else if (t < T2) { const int q = t - T1, tq = q / 16, tk = q % 16, c = tq * 256; const float sc = (tq >= 2 && tq < 4) ? 0.08838834764831845f : 1.0f;
            transpose_quad(tile, gla_w_in, 3088, c, c + 64, c + 128, c + 192, (bf16_t*)(ws + WS_WGI), 1024, c, tk, sc, a.in[5] + DM, 3088); }
        else if (t < T3) { const int q = t - T2, tq = q / 16, tk = q % 16, c = tq * 256; transpose_quad(tile, gla_w_out, 1024, c, c + 64, c + 128, c + 192, (bf16_t*)(ws + WS_WGO), 1024, c, tk, 1.0f); }
        else if (t < T4) { int q = t - T3; const int l = q / (22 * 16); q %= 22 * 16; const int tq = q / 16, tk = q % 16, g0 = 128 * tq;
            transpose_quad(tile, ffn_w_up + (size_t)l * 1024 * FF2, FF2, g0, g0 + 64, FF + g0, FF + g0 + 64, (bf16_t*)(ws + WS_WUP) + (size_t)l * FF2 * 1024, 1024, tq * 256, tk, 1.0f, a.in[6] + l * DM); }
        else { int q = t - T4; const int l = q / (4 * 44); q %= 4 * 44; const int tq = q / 44, tk = q % 44, c = tq * 256;
            transpose_quad(tile, ffn_w_down + (size_t)l * FF * 1024, 1024, c, c + 64, c + 128, c + 192, (bf16_t*)(ws + WS_WDN) + (size_t)l * 1024 * FF, FF, c, tk, 1.0f); }
    }
}

__device__ __forceinline__ void prep_phase(LAS unsigned char* lds, const Args& a) {
    unsigned char* ws = a.ws;
    LAS float* tile = (LAS float*)lds;
    const float* ret_w_in = a.in[8]; const float* ret_w_out = a.in[10]; const float* gla_w_in = a.in[11]; const float* gla_w_a2 = a.in[12];
    const float* gla_w_out = a.in[15]; const float* ffn_w_up = a.in[16]; const float* ffn_w_down = a.in[19];
    weight_jobs(lds, a, 0, bidx(), gridDim.x);
    const int gtid = bidx() * 512 + tidx(), gthreads = gridDim.x * 512;
    f32x2* rot = (f32x2*)(ws + WS_ROT);
    { const int d = gtid & 127; const double inv = exp(-(double)d * (9.210340371976184 / 128.0));
      for (int pos = gtid >> 7; pos < 8192; pos += gthreads >> 7) {
          const double ang = (double)pos * inv; const double red = ang - 6.283185307179586 * rint(ang * 0.15915494309189535);
          const float rf = (float)red; rot[pos * 128 + d] = (f32x2){cosf(rf), sinf(rf)}; } }
    for (int i = gtid; i < 3 * MT_; i += gthreads) ((float*)(ws + WS_SS))[i] = 0.f;
    norm_phase(a.in[0], (float*)a.in[1], a.in[5], (bf16_t*)(ws + WS_H), nullptr);
}

template <bool RET>
__device__ __forceinline__ void onorm_phase(bf16_t* big, int ld, int ocol, int gcol, const float* gn, int dry) {
    const int tid_ = tidx(), lane = tid_ & 63, wv = bidx() * 8 + (tid_ >> 6), nw = gridDim.x * 8;
    constexpr int DV = RET ? 512 : 256, PER = DV / 64, NW = PER / 2;
    for (int r0 = wv; r0 < MT_; r0 += 2 * nw) {
        unsigned ow[2][4][NW], gw[2][4][NW];
#pragma unroll
        for (int u = 0; u < 2; ++u) { const int r = r0 + u * nw; if (r < MT_) {
#pragma unroll
            for (int h = 0; h < 4; ++h) {
                const bf16_t* op = big + (size_t)r * ld + ocol + h * DV + lane * PER; const bf16_t* gp = big + (size_t)r * ld + gcol + h * DV + lane * PER;
                if (RET) { const u32x4 a = *(const u32x4*)op, b = *(const u32x4*)gp; ow[u][h][0] = a.x; ow[u][h][1] = a.y; ow[u][h][2 % NW] = a.z; ow[u][h][3 % NW] = a.w; gw[u][h][0] = b.x; gw[u][h][1] = b.y; gw[u][h][2 % NW] = b.z; gw[u][h][3 % NW] = b.w; }
                else { const u32x2 a = *(const u32x2*)op, b = *(const u32x2*)gp; ow[u][h][0] = a.x; ow[u][h][1] = a.y; gw[u][h][0] = b.x; gw[u][h][1] = b.y; }
            } } }
#pragma unroll
        for (int u = 0; u < 2; ++u) { const int r = r0 + u * nw; if (r < MT_) {
#pragma unroll
            for (int h = 0; h < 4; ++h) {
                float o[PER], g[PER];
#pragma unroll
                for (int i = 0; i < NW; ++i) { o[2 * i] = bf_lo(ow[u][h][i]); o[2 * i + 1] = bf_hi(ow[u][h][i]); g[2 * i] = bf_lo(gw[u][h][i]); g[2 * i + 1] = bf_hi(gw[u][h][i]); }
                float sm = 0.f;
#pragma unroll
                for (int i = 0; i < PER; ++i) sm += RET ? o[i] : o[i] * o[i];
#pragma unroll
                for (int x = 32; x >= 1; x >>= 1) sm += __shfl_xor(sm, x);
                float mu = 0.f, rstd;
                if (RET) { mu = sm * (1.0f / DV); float q = 0.f;
#pragma unroll
                    for (int i = 0; i < PER; ++i) { const float d = o[i] - mu; q += d * d; }
#pragma unroll
                    for (int x = 32; x >= 1; x >>= 1) q += __shfl_xor(q, x);
                    rstd = rsqrtf(q * (1.0f / DV) + EPS);
                } else rstd = rsqrtf(sm * (1.0f / DV) + EPS);
                unsigned yw[NW];
#pragma unroll
                for (int i = 0; i < NW; ++i) { const f32x2 wv2 = *(const f32x2*)(gn + h * DV + lane * PER + 2 * i);
                    yw[i] = pk(silu(g[2 * i]) * ((o[2 * i] - mu) * rstd * wv2[0]), silu(g[2 * i + 1]) * ((o[2 * i + 1] - mu) * rstd * wv2[1])); }
                bf16_t* gp = big + (size_t)r * ld + gcol + h * DV + lane * PER;
                if (!dry) { if (RET) { u32x4 w4; w4.x = yw[0]; w4.y = yw[1]; w4.z = yw[2 % NW]; w4.w = yw[3 % NW]; *(u32x4*)gp = w4; }
                else { u32x2 w2; w2.x = yw[0]; w2.y = yw[1]; *(u32x2*)gp = w2; } }
            } } }
    }
}

constexpr int CSEG = 32, NSEGP = MP / CSEG, NSEG = NSEGP + 8;
__device__ __forceinline__ void halo_phase(const bf16_t* u, bf16_t* halo, float* convP, float* convS) {
    const int gtid = bidx() * 512 + tidx(), gthreads = gridDim.x * 512;
    for (int i = gtid; i < NSEGP * 704; i += gthreads) {
        const int sg = i / 704, p = i % 704; if ((sg & (SEQ / CSEG - 1)) == 0) continue;
        const int jj = p / 352, pc = p % 352;
        const u32x4 v = *(const u32x4*)(u + (size_t)(sg * CSEG - 2 + jj) * FF2 + pc * 8);
        *(u32x4*)(halo + ((size_t)sg * 2 + jj) * FF + pc * 8) = v;
    }
    for (int i = gtid; i < 16 * 2 * (FF2 / 2); i += gthreads) {
        const int c2 = i % (FF2 / 2), jj = (i / (FF2 / 2)) & 1, sq = i / FF2;
        const int row = sq < 8 ? sq * SEQ + SEQ - 2 + jj : MP + (sq - 8) * DSEQ + DSEQ - 2 + jj;
        const unsigned w = *(const unsigned*)(u + (size_t)row * FF2 + 2 * c2);
        float* dst = (sq < 8 ? convP + ((size_t)sq * 2 + jj) * FF2 : convS + ((size_t)(sq - 8) * 2 + jj) * FF2) + 2 * c2;
        *(f32x2*)dst = (f32x2){bf_lo(w), bf_hi(w)};
    }
}
__device__ __forceinline__ void conv_phase(bf16_t* u, const bf16_t* halo, const float* cw, const float* cb, const float* cache, int dry) {
    const int gtid = bidx() * 512 + tidx(), gthreads = gridDim.x * 512;
    for (int i = gtid; i < NSEG * (FF / 4); i += gthreads) {
        const int sg = i / (FF / 4), c = 4 * (i % (FF / 4));
        const bool samp = sg >= NSEGP; const int row0 = samp ? MP + (sg - NSEGP) * DSEQ : sg * CSEG;
        const f32x4 wg0 = *(const f32x4*)(cw + c), wg1 = *(const f32x4*)(cw + FF2 + c), wg2 = *(const f32x4*)(cw + 2 * FF2 + c), bg = *(const f32x4*)(cb + c);
        const f32x4 wv0 = *(const f32x4*)(cw + FF + c), wv1 = *(const f32x4*)(cw + FF2 + FF + c), wv2 = *(const f32x4*)(cw + 2 * FF2 + FF + c), bv = *(const f32x4*)(cb + FF + c);
        f32x4 g2, g1, v2, v1;
        if (samp) { const float* cs = cache + (size_t)(sg - NSEGP) * 2 * FF2; g2 = *(const f32x4*)(cs + c); g1 = *(const f32x4*)(cs + FF2 + c); v2 = *(const f32x4*)(cs + FF + c); v1 = *(const f32x4*)(cs + FF2 + FF + c); }
        else if ((sg & (SEQ / CSEG - 1)) == 0) { g2 = g1 = v2 = v1 = (f32x4){0.f, 0.f, 0.f, 0.f}; }
        else { g2 = bf4(*(const u32x2*)(halo + ((size_t)sg * 2) * FF + c)); g1 = bf4(*(const u32x2*)(halo + ((size_t)sg * 2 + 1) * FF + c));
            v2 = bf4(*(const u32x2*)(u + (size_t)(row0 - 2) * FF2 + FF + c)); v1 = bf4(*(const u32x2*)(u + (size_t)(row0 - 1) * FF2 + FF + c)); }
#pragma unroll 1
        for (int t0 = 0; t0 < CSEG; t0 += 8) {
            u32x2 gw[8], vw[8];
#pragma unroll
            for (int j = 0; j < 8; ++j) { const bf16_t* rp = u + (size_t)(row0 + t0 + j) * FF2 + c; gw[j] = *(const u32x2*)rp; vw[j] = *(const u32x2*)(rp + FF); }
            u32x2 ow[8];
#pragma unroll
            for (int j = 0; j < 8; ++j) {
                const f32x4 g0 = bf4(gw[j]), v0 = bf4(vw[j]);
                const f32x4 cgv = bg + g2 * wg0 + g1 * wg1 + g0 * wg2, cvv = bv + v2 * wv0 + v1 * wv1 + v0 * wv2;
                ow[j].x = pk(silu(cgv[0]) * cvv[0], silu(cgv[1]) * cvv[1]); ow[j].y = pk(silu(cgv[2]) * cvv[2], silu(cgv[3]) * cvv[3]);
                g2 = g1; g1 = g0; v2 = v1; v1 = v0;
            }
#pragma unroll
            for (int j = 0; j < 8; ++j) if (!dry) *(u32x2*)(u + (size_t)(row0 + t0 + j) * FF2 + c) = ow[j];
        }
    }
}

__device__ __forceinline__ void glaprep_phase(bf16_t* big, const bf16_t* a16, const float* w_a2, const float* b_a, float* eb, int dry) {
    const int gtid = bidx() * 512 + tidx(), gthreads = gridDim.x * 512;
    for (int i = gtid; i < NCHUNK * 128; i += gthreads) {
        const int ch = i >> 7, c = 4 * (i & 127);
        const bool samp = ch >= 1024; const int row0 = samp ? MP + (ch - 1024) * DSEQ : ch * 64; const int len = samp ? DSEQ : 64;
        f32x4 W[16];
#pragma unroll
        for (int r = 0; r < 16; ++r) W[r] = *(const f32x4*)(w_a2 + r * 512 + c);
        const f32x4 bias = *(const f32x4*)(b_a + c);
        f32x4 b = {0.f, 0.f, 0.f, 0.f};
#pragma unroll 1
        for (int t0 = 0; t0 < len; t0 += 8) {
            u32x4 aw[8][2]; u32x2 qw[8], kw[8];
#pragma unroll
            for (int j = 0; j < 8; ++j) { const size_t r = row0 + t0 + j; aw[j][0] = *(const u32x4*)(a16 + r * 16); aw[j][1] = *(const u32x4*)(a16 + r * 16 + 8); qw[j] = *(const u32x2*)(big + r * GLA_NB + c); kw[j] = *(const u32x2*)(big + r * GLA_NB + 512 + c); }
#pragma unroll
            for (int j = 0; j < 8; ++j) { const size_t r = row0 + t0 + j;
                const unsigned aa[8] = {aw[j][0].x, aw[j][0].y, aw[j][0].z, aw[j][0].w, aw[j][1].x, aw[j][1].y, aw[j][1].z, aw[j][1].w};
                f32x4 z = bias;
#pragma unroll
                for (int x = 0; x < 8; ++x) { z += W[2 * x] * bf_lo(aa[x]); z += W[2 * x + 1] * bf_hi(aa[x]); }
#pragma unroll
                for (int x = 0; x < 4; ++x) b[x] += (fminf(z[x], 0.f) - __logf(1.0f + __expf(-fabsf(z[x])))) * 0.0625f;
                const f32x4 q = bf4(qw[j]), k = bf4(kw[j]); f32x4 e, ie;
#pragma unroll
                for (int x = 0; x < 4; ++x) { e[x] = __expf(b[x]); ie[x] = __expf(-b[x]); }
                u32x2 w; w.x = pk(q[0] * e[0], q[1] * e[1]); w.y = pk(q[2] * e[2], q[3] * e[3]); if (!dry) *(u32x2*)(big + r * GLA_NB + c) = w;
                w.x = pk(k[0] * ie[0], k[1] * ie[1]); w.y = pk(k[2] * ie[2], k[3] * ie[3]); if (!dry) *(u32x2*)(big + r * GLA_NB + 512 + c) = w; }
        }
        f32x4 e;
#pragma unroll
        for (int x = 0; x < 4; ++x) e[x] = __expf(b[x]);
        *(f32x4*)(eb + (size_t)ch * 512 + c) = e;
    }
}

struct ScanArgs { bf16_t* big; int ld, qoff, koff, voff; const float* eb; const float* S0; float* SoutP; float* SoutS; };
template <int DK, int DV, int NCG, bool GLA>
__device__ __forceinline__ void scan_phase(LAS unsigned char* lds, const ScanArgs& a) {
    constexpr int NTG = 8 / NCG, TW = 64 / NTG, MT = TW / 16, NT = DK / 16, KS = DK / 32, QP = DK + 8, TP = 72, SLICE = 16 * NCG, NS = DV / SLICE, VP = SLICE + 8;
    constexpr int NTL = NT / NTG, KSL = KS / NTG, DKL = DK / NTG;
    constexpr int NPQ = DK / 64;
    static_assert(NS == 8 && KSL >= 1 && NTL == 2 * KSL, "scan geometry");
    LAS bf16_t* Qs = (LAS bf16_t*)lds; LAS bf16_t* Ks = Qs + 64 * QP; LAS bf16_t* Vs = Ks + 64 * QP; LAS bf16_t* Ps = Vs + 64 * VP;
    LAS f32x4* XCH = (LAS f32x4*)(Ps + 64 * TP);
    static_assert(((64 * QP * 2 + 64 * VP + 64 * TP) * 2) % 16 == 0 && (64 * QP * 2 + 64 * VP + 64 * TP) * 2 + 8 * 4 * 64 * 16 <= LDS_MAIN, "scan LDS");
    const int tid = tidx(), bid = bidx(), wave = __builtin_amdgcn_readfirstlane(tid >> 6), lane = tid & 63, fr = lane & 15, fq = lane >> 4;
    const int cgi = wave % NCG, tg = wave / NCG;
    const int trK = (8 * fq + (fr >> 2)) * QP + 4 * (fr & 3), trV = (8 * fq + (fr >> 2)) * VP + 4 * (fr & 3);
#define TR_FRAG(ptr, pitch) ({ const s16x4 lo_ = __builtin_amdgcn_ds_read_tr16_b64_v4i16((LAS s16x4*)(ptr)), hi_ = __builtin_amdgcn_ds_read_tr16_b64_v4i16((LAS s16x4*)((ptr) + 4 * (pitch))); (bf16x8)__builtin_shufflevector(lo_, hi_, 0, 1, 2, 3, 4, 5, 6, 7); })
    for (int ui = 0; ui < 2; ++ui) {
        const bool samp = ui == 1;
        const int x = bid & 7, j = bid >> 3;
        const int bh = x + 8 * (j >> 3), s = j & 7, b = bh >> 2, h = bh & 3;
        if (bh >= 32) continue;
        const int row0 = samp ? MP + b * DSEQ : b * SEQ, L = samp ? DSEQ : 64, nch = samp ? 1 : SEQ / 64;
        const bf16_t* qb = a.big + a.qoff + h * DK; const bf16_t* kb = a.big + a.koff + h * DK; bf16_t* vb = a.big + a.voff + h * DV + s * SLICE;
        f32x4 S[NTL];
        int loff = (DKL * tg + 4 * fq) * DV + 16 * cgi + fr;
        asm volatile("" : "+v"(loff));
        if (samp) {
            const float* s0 = a.S0 + (size_t)(b * 4 + h) * DK * DV + s * SLICE + loff;
#pragma unroll
            for (int t = 0; t < NTL; ++t)
#pragma unroll
                for (int r = 0; r < 4; ++r) S[t][r] = s0[(16 * t + r) * DV];
        } else {
#pragma unroll
            for (int t = 0; t < NTL; ++t) S[t] = (f32x4){0.f, 0.f, 0.f, 0.f};
        }
        const float lgam = h == 0 ? -0.031748698314580f : h == 1 ? -0.015748356968139f : h == 2 ? -0.007843177461025f : -0.003913899321136f;
        const float dsc = __expf((float)L * lgam);
        u32x4 qreg[NPQ], kreg[NPQ], vreg;
        f32x4 dreg[GLA ? NTL : 1];
#define SCAN_LOAD(c) do { const size_t rc = (size_t)row0 + (size_t)(c) * 64; \
        _Pragma("unroll") for (int i = 0; i < NPQ; ++i) { const int p = tid + 512 * i; const int t = p / (DK / 8), dg = p % (DK / 8); \
            qreg[i] = t < L ? *(const u32x4*)(qb + (rc + t) * a.ld + 8 * dg) : (u32x4){0u, 0u, 0u, 0u}; } \
        _Pragma("unroll") for (int i = 0; i < NPQ; ++i) { const int p = tid + 512 * i; const int t = p / (DK / 8), dg = p % (DK / 8); \
            kreg[i] = t < L ? *(const u32x4*)(kb + (rc + t) * a.ld + 8 * dg) : (u32x4){0u, 0u, 0u, 0u}; } \
        { const int t = tid / (SLICE / 8), cp = tid % (SLICE / 8); vreg = (t < 64 && t < L) ? *(const u32x4*)(vb + (rc + t) * a.ld + 8 * cp) : (u32x4){0u, 0u, 0u, 0u}; } \
        if (GLA) { const float* ebp = a.eb + (size_t)(samp ? 1024 + b : b * 128 + (c)) * 512 + h * DK + DKL * tg; \
            _Pragma("unroll") for (int t = 0; t < (GLA ? NTL : 1); ++t) dreg[t] = *(const f32x4*)(ebp + 16 * t + 4 * fq); } } while (0)
        SCAN_LOAD(0);
        for (int c = 0; c < nch; ++c) {
#pragma unroll
            for (int i = 0; i < NPQ; ++i) { const int p = tid + 512 * i; const int t = p / (DK / 8), dg = p % (DK / 8); *(LAS u32x4*)(Qs + t * QP + 8 * dg) = qreg[i]; }
#pragma unroll
            for (int i = 0; i < NPQ; ++i) { const int p = tid + 512 * i; const int t = p / (DK / 8), dg = p % (DK / 8); *(LAS u32x4*)(Ks + t * QP + 8 * dg) = kreg[i]; }
            { const int t = tid / (SLICE / 8), cp = tid % (SLICE / 8); if (t < 64) *(LAS u32x4*)(Vs + t * VP + 8 * cp) = vreg; }
            f32x4 dcur[GLA ? NTL : 1];
#pragma unroll
            for (int t = 0; t < (GLA ? NTL : 1); ++t) dcur[t] = dreg[t];
            __syncthreads();
            if (c + 1 < nch) SCAN_LOAD(c + 1);
#pragma unroll
            for (int tt = 0; tt < 2; ++tt) {
                const int t = wave + 8 * tt, it = t >> 2, jt = t & 3;
                f32x4 p = {0.f, 0.f, 0.f, 0.f};
                if (jt <= it) {
#pragma unroll
                    for (int ks = 0; ks < KS; ++ks) {
                        const bf16x8 ak = *(const LAS bf16x8*)(Ks + (16 * jt + fr) * QP + 32 * ks + 8 * fq);
                        const bf16x8 bq = *(const LAS bf16x8*)(Qs + (16 * it + fr) * QP + 32 * ks + 8 * fq);
                        p = MFMA16(ak, bq, p);
                        if ((ks & 3) == 3) asm volatile("" ::: "memory");
                    }
                    if (jt == it) {
#pragma unroll
                        for (int r = 0; r < 4; ++r) if (4 * fq + r > fr) p[r] = 0.f;
                    }
                }
                u32x2 w; w.x = pk(p[0], p[1]); w.y = pk(p[2], p[3]);
                *(LAS u32x2*)(Ps + (16 * it + fr) * TP + 16 * jt + 4 * fq) = w;
            }
            f32x4 op[4];
#pragma unroll
            for (int i = 0; i < 4; ++i) op[i] = (f32x4){0.f, 0.f, 0.f, 0.f};
#pragma unroll
            for (int ks = 0; ks < KSL; ++ks) {
                u32x4 sp; sp.x = pk(S[2 * ks][0], S[2 * ks][1]); sp.y = pk(S[2 * ks][2], S[2 * ks][3]); sp.z = pk(S[2 * ks + 1][0], S[2 * ks + 1][1]); sp.w = pk(S[2 * ks + 1][2], S[2 * ks + 1][3]);
                const bf16x8 sa = __builtin_bit_cast(bf16x8, sp);
#pragma unroll
                for (int i = 0; i < 4; ++i) {
                    const int tt = (MT * tg + i) & 3;
                    const LAS bf16_t* qp = Qs + (16 * tt + fr) * QP + DKL * tg + 32 * ks + 4 * fq;
                    const s16x4 lo = *(const LAS s16x4*)qp, hi = *(const LAS s16x4*)(qp + 16);
                    const bf16x8 bq = __builtin_shufflevector(lo, hi, 0, 1, 2, 3, 4, 5, 6, 7);
                    op[i] = MFMA16(sa, bq, op[i]);
                }
                asm volatile("" ::: "memory");
            }
#pragma unroll
            for (int i = MT; i < 4; ++i) { const int tt = (MT * tg + i) & 3; XCH[(wave * 4 + tt) * 64 + lane] = op[i]; }
            __syncthreads();
            f32x4 o[MT];
#pragma unroll
            for (int mt = 0; mt < MT; ++mt) {
                o[mt] = op[mt];
#pragma unroll
                for (int d = 1; d < NTG; ++d) { const int pw = cgi + NCG * ((tg + d) % NTG); o[mt] += XCH[(pw * 4 + MT * tg + mt) * 64 + lane]; }
            }
            bf16x8 vt[2];
#pragma unroll
            for (int ks = 0; ks < 2; ++ks) vt[ks] = TR_FRAG(Vs + trV + 32 * ks * VP + 16 * cgi, VP);
#pragma unroll
            for (int mt = 0; mt < MT; ++mt)
#pragma unroll
                for (int ks = 0; ks < 2; ++ks) {
                    const bf16x8 bp = *(const LAS bf16x8*)(Ps + (TW * tg + 16 * mt + fr) * TP + 32 * ks + 8 * fq);
                    o[mt] = MFMA16(vt[ks], bp, o[mt]);
                }
#pragma unroll
            for (int mt = 0; mt < MT; ++mt) {
                const int tok = TW * tg + 16 * mt + fr;
                if (tok < L) { u32x2 w; w.x = pk(o[mt][0], o[mt][1]); w.y = pk(o[mt][2], o[mt][3]);
                    *(u32x2*)(vb + ((size_t)row0 + (size_t)c * 64 + tok) * a.ld + 16 * cgi + 4 * fq) = w; }
            }
#pragma unroll
            for (int t = 0; t < NTL; ++t) {
#pragma unroll
                for (int ks = 0; ks < 2; ++ks) {
                    const bf16x8 ak = TR_FRAG(Ks + trK + 32 * ks * QP + DKL * tg + 16 * t, QP);
                    S[t] = MFMA16(ak, vt[ks], S[t]);
                }
                if (GLA) S[t] = S[t] * dcur[GLA ? t : 0]; else S[t] = S[t] * dsc;
                if (t & 1) asm volatile("" ::: "memory");
            }
            __syncthreads();
        }
#undef SCAN_LOAD
        {
            int loff2 = (DKL * tg + 4 * fq) * DV + 16 * cgi + fr;
            asm volatile("" : "+v"(loff2));
            float* so = (samp ? a.SoutS : a.SoutP) + (size_t)(b * 4 + h) * DK * DV + s * SLICE + loff2;
#pragma unroll
            for (int t = 0; t < NTL; ++t)
#pragma unroll
                for (int r = 0; r < 4; ++r) so[(16 * t + r) * DV] = S[t][r];
        }
    }
}

constexpr int NPHASE = 20;
constexpr int LDS_BYTES = LDS_MAIN + 16;

typedef const __attribute__((address_space(4))) Args* KArgs;
#define ARGS() ({ KArgs p_ = ka0; asm volatile("" : "+s"(p_)); p_; })
#ifndef PROBE_MASK
#define PROBE_MASK 0
#endif
#define REP(bit, body) do { for (int rp_ = (PROBE_MASK >> (bit)) & 1; rp_ >= 0; --rp_) { const int dry = rp_; (void)dry; body; if (rp_) xcd_barrier(bar); } } while (0)

__global__ void __launch_bounds__(512, 2) mk_fwd(Args a_unused) {
    extern __shared__ __attribute__((aligned(16))) unsigned char lds_raw[];
    LAS unsigned char* lds = (LAS unsigned char*)lds_raw;
    const KArgs ka0 = (KArgs)__builtin_amdgcn_kernarg_segment_ptr();
    const int lo = ka0->ph_lo, hi = ka0->ph_hi;
    XcdBarrier bar; bar.bar = (unsigned*)ka0->ws; bar.x = 0; bar.st = (volatile LAS unsigned*)(lds + LDS_MAIN);
    if (hi - lo > 1) {
        if (threadIdx.x < 4) ((LAS unsigned*)(lds + LDS_MAIN))[threadIdx.x] = 0u;
        __syncthreads();
        bar = xcd_barrier_post((unsigned*)ka0->ws, (volatile LAS unsigned*)(lds + LDS_MAIN));
    }
#define IN(k) (lo <= (k) && (k) < hi)
#define SEAM(k) do { if (IN(k) && IN((k) + 1)) { xcd_barrier(bar); } } while (0)
#define WSP(off) (A->ws + (off))
#define XRES (A->out)
    if (IN(0)) { KArgs A = ARGS(); Args av;
#pragma unroll
        for (int i = 0; i < 20; ++i) av.in[i] = A->in[i];
        av.out = A->out; av.ws = A->ws; av.ph_lo = 0; av.ph_hi = 0; REP(0, prep_phase(lds, av)); }
    if (lo < -1) cg::this_grid().sync();
    SEAM(0);
    if (IN(1)) { KArgs A = ARGS(); pg8::Gemm g{(const bf16_t*)WSP(WS_H), (const bf16_t*)WSP(WS_WRI), MT_, RET_N, 1024, 1024}; pg8::StaticOrder S; S.init(MT_, RET_N, 1024, gridDim.x, bidx(), 0);
        Epi<1> E{}; E.O = (bf16_t*)WSP(WS_BIG); E.ldc = RET_N; E.rot = (const f32x2*)WSP(WS_ROT); REP(1, pg8::gemm_phase(lds, g, S, E));
        { const int b_ = bidx(); if (b_ >= 24) { Args av;
#pragma unroll
            for (int i = 0; i < 20; ++i) av.in[i] = A->in[i];
            av.out = A->out; av.ws = A->ws; av.ph_lo = 0; av.ph_hi = 0; weight_jobs(lds, av, 1, b_ - 24, (int)gridDim.x - 24); } } } SEAM(1);
    if (IN(2)) { KArgs A = ARGS(); ScanArgs sa{(bf16_t*)WSP(WS_BIG), RET_N, 0, 1024, 2048, nullptr, A->in[2], A->out + O_RETP, A->out + O_RETS}; scan_phase<256, 512, 4, false>(lds, sa); } SEAM(2);
    if (IN(3)) { KArgs A = ARGS(); REP(2, onorm_phase<true>((bf16_t*)WSP(WS_BIG), RET_N, 2048, 4096, A->in[9], dry)); } SEAM(3);
    if (IN(4)) { KArgs A = ARGS(); pg8::Gemm g{(const bf16_t*)WSP(WS_BIG) + 4096, (const bf16_t*)WSP(WS_WRO), MT_, 1024, 2048, RET_N}; pg8::StaticOrder S; S.init(MT_, 1024, 2048, gridDim.x, bidx(), 4);
        Epi<2> E{}; E.resP = A->in[0]; E.resS = A->in[1]; E.tmp = (float*)WSP(WS_TMP); E.xb = (bf16_t*)WSP(WS_H); E.ssw = (float*)WSP(WS_SSP); pg8::gemm_phase(lds, g, S, E); } SEAM(4);
#pragma unroll 1
    for (int l = 0; l < 2; ++l) {
        const int pb = l == 0 ? 5 : 15;
        if (IN(pb)) { KArgs A = ARGS(); samplenorm_phase((bf16_t*)WSP(WS_H) + (size_t)MP * DM, (float*)WSP(WS_SS) + (size_t)(2 * l) * MT_ + MP, (const float*)WSP(WS_TMP), (const float*)WSP(WS_SSP)); } SEAM(pb);
        if (IN(pb + 1)) { KArgs A = ARGS(); pg8::Gemm g{(const bf16_t*)WSP(WS_H), (const bf16_t*)WSP(WS_WUP) + (size_t)l * FF2 * 1024, MT_, FF2, 1024, 1024}; pg8::StaticOrder S; S.init(MT_, FF2, 1024, gridDim.x, bidx(), 5);
            EpiConv E{(bf16_t*)WSP(WS_ACT), (bf16_t*)WSP(WS_HEAD), (bf16_t*)WSP(WS_EDGE), A->in[17] + (size_t)l * 3 * FF2, A->in[18] + (size_t)l * FF2, (float*)WSP(WS_USLAB), (const float*)WSP(WS_SS) + (size_t)(2 * l) * MT_}; pg8::gemm_phase(lds, g, S, E); } SEAM(pb + 1);
        if (IN(pb + 2)) { KArgs A = ARGS(); convfix_phase((bf16_t*)WSP(WS_ACT), (const bf16_t*)WSP(WS_HEAD), (const bf16_t*)WSP(WS_EDGE), A->in[17] + (size_t)l * 3 * FF2, A->in[18] + (size_t)l * FF2, A->in[4] + (size_t)l * 8 * 2 * FF2,
            A->out + O_CONVP + (size_t)l * 8 * 2 * FF2, A->out + O_CONVS + (size_t)l * 8 * 2 * FF2, (const float*)WSP(WS_USLAB), (const float*)WSP(WS_SS) + (size_t)(2 * l) * MT_); } SEAM(pb + 2);
        if (IN(pb + 3)) { KArgs A = ARGS(); pg8::Gemm g{(const bf16_t*)WSP(WS_ACT), (const bf16_t*)WSP(WS_WDN) + (size_t)l * 1024 * FF, MT_, 1024, FF, FF}; pg8::StaticOrder S; S.init(MT_, 1024, FF, gridDim.x, bidx(), 4);
            Epi<2> E{}; E.tmp = (float*)WSP(WS_TMP); E.xb = (bf16_t*)WSP(WS_H); if (l == 0) E.ssw = (float*)WSP(WS_SSP); pg8::gemm_phase(lds, g, S, E); } SEAM(pb + 3);
        if (l == 0) {
            if (IN(9)) { KArgs A = ARGS(); samplenorm_phase((bf16_t*)WSP(WS_H) + (size_t)MP * DM, (float*)WSP(WS_SS) + MT_ + MP, (const float*)WSP(WS_TMP), (const float*)WSP(WS_SSP)); } SEAM(9);
            if (IN(10)) { KArgs A = ARGS(); pg8::Gemm g{(const bf16_t*)WSP(WS_H), (const bf16_t*)WSP(WS_WGI), MT_, GLA_N, 1024, 1024}; pg8::StaticOrder S; S.init(MT_, GLA_N, 1024, gridDim.x, bidx(), 0);
                Epi<3> E{}; E.O = (bf16_t*)WSP(WS_BIG); E.ldc = GLA_NB; E.lg = (bf16_t*)WSP(WS_LG); E.b_a = A->in[13]; E.ssr = (const float*)WSP(WS_SS) + MT_; pg8::gemm_phase(lds, g, S, E);
                { const int b_ = bidx(); if (b_ >= 13) { Args av;
#pragma unroll
                    for (int i = 0; i < 20; ++i) av.in[i] = A->in[i];
                    av.out = A->out; av.ws = A->ws; av.ph_lo = 0; av.ph_hi = 0; weight_jobs(lds, av, 2, b_ - 13, (int)gridDim.x - 13); } } } SEAM(10);
            if (IN(11)) { KArgs A = ARGS(); REP(6, glaprep_phase((bf16_t*)WSP(WS_BIG), (const bf16_t*)WSP(WS_LG), A->in[12], A->in[13], (float*)WSP(WS_EB), dry)); } SEAM(11);
            if (IN(12)) { KArgs A = ARGS(); ScanArgs sa{(bf16_t*)WSP(WS_BIG), GLA_NB, 0, 512, 1024, (const float*)WSP(WS_EB), A->in[3], A->out + O_GLAP, A->out + O_GLAS}; scan_phase<128, 256, 2, true>(lds, sa); } SEAM(12);
            if (IN(13)) { KArgs A = ARGS(); REP(2, onorm_phase<false>((bf16_t*)WSP(WS_BIG), GLA_NB, 1024, 2048, A->in[14], dry)); } SEAM(13);
            if (IN(14)) { KArgs A = ARGS(); pg8::Gemm g{(const bf16_t*)WSP(WS_BIG) + 2048, (const bf16_t*)WSP(WS_WGO), MT_, 1024, 1024, GLA_NB}; pg8::StaticOrder S; S.init(MT_, 1024, 1024, gridDim.x, bidx(), 4);
                Epi<2> E{}; E.tmp = (float*)WSP(WS_TMP); E.xb = (bf16_t*)WSP(WS_H); E.ssw = (float*)WSP(WS_SSP); pg8::gemm_phase(lds, g, S, E); } SEAM(14);
        }
    }
    if (IN(19)) { KArgs A = ARGS(); REP(7, final_norm_phase((const bf16_t*)WSP(WS_H), A->out, A->in[7], dry, (const float*)WSP(WS_TMP))); }
#undef IN
#undef SEAM
}

extern "C" void kernel_launch(void* const* d_in, const int* in_sizes, int n_in, void* d_out, int out_size, void* d_ws, size_t ws_size, hipStream_t stream) {
    static int grid = 0;
    if (grid == 0) {
        if (n_in != 20 || (size_t)out_size != O_END || ws_size < WS_END) { fprintf(stderr, "kernel_launch: unexpected shapes (n_in %d out %d ws %zu need %zu)\n", n_in, out_size, ws_size, (size_t)WS_END); grid = -1; return; }
        if (hipFuncSetAttribute((const void*)mk_fwd, hipFuncAttributeMaxDynamicSharedMemorySize, LDS_BYTES) != hipSuccess) { fprintf(stderr, "kernel_launch: hipFuncSetAttribute failed\n"); grid = -1; return; }
        int dev = 0, cus = 0, per_cu = 0;
        hipGetDevice(&dev); hipDeviceGetAttribute(&cus, hipDeviceAttributeMultiprocessorCount, dev);
        hipOccupancyMaxActiveBlocksPerMultiprocessor(&per_cu, (const void*)mk_fwd, 512, LDS_BYTES);
        if (per_cu < 1) { fprintf(stderr, "kernel_launch: occupancy query says %d blocks/CU\n", per_cu); per_cu = 1; }
        (void)hipGetLastError();
        grid = cus;
    }
    if (grid < 0) return;
    if (hipMemsetAsync(d_ws, 0, 16384, stream) != hipSuccess) { fprintf(stderr, "kernel_launch: memset failed\n"); return; }
    Args a{};
    for (int i = 0; i < 20; ++i) a.in[i] = (const float*)d_in[i];
    a.out = (float*)d_out; a.ws = (unsigned char*)d_ws;
#if MK_ONE_LAUNCH
    a.ph_lo = 0; a.ph_hi = NPHASE;
    void* args[] = {&a};
    hipError_t e = hipLaunchCooperativeKernel((const void*)mk_fwd, dim3(grid), dim3(512), args, LDS_BYTES, stream);
    if (e != hipSuccess) fprintf(stderr, "cooperative launch failed: %s (grid %d)\n", hipGetErrorString(e), grid);
#else
    for (int p = 0; p < NPHASE; ++p) {
        a.ph_lo = p; a.ph_hi = p + 1;
        hipLaunchKernelGGL(mk_fwd, dim3(grid), dim3(512), LDS_BYTES, stream, a);
    }
#endif
}
```

```cpp
#include <hip/hip_runtime.h>
#include <hip/hip_cooperative_groups.h>
#include <cstdio>
namespace cg = cooperative_groups;

#ifndef MK_ONE_LAUNCH
#define MK_ONE_LAUNCH 1
#endif

#define LAS __attribute__((address_space(3)))
typedef unsigned short bf16_t;
typedef short bf16x8 __attribute__((ext_vector_type(8)));
typedef short s16x4 __attribute__((ext_vector_type(4)));
typedef float f32x4 __attribute__((ext_vector_type(4)));
typedef float f32x2 __attribute__((ext_vector_type(2)));
typedef unsigned u32x4 __attribute__((ext_vector_type(4)));
typedef unsigned u32x2 __attribute__((ext_vector_type(2)));
typedef __bf16 bf16v2 __attribute__((ext_vector_type(2)));

constexpr int LDS_MAIN = 155648;
constexpr int DM = 1024;
constexpr int MP = 65536;
constexpr int MS = 256;
constexpr int MT_ = MP + MS;
constexpr int SEQ = 8192, DSEQ = 32, PAST = 2048;
constexpr int FF = 2816, FF2 = 5632;
constexpr int RET_N = 6144;
constexpr int GLA_NB = 3072;
constexpr int GLA_N = 3328;
constexpr int NCHUNK = 1032;
constexpr float EPS = 1e-6f;

constexpr size_t O_Y = 0;
constexpr size_t O_RETP = (size_t)MT_ * DM;
constexpr size_t O_RETS = O_RETP + 4194304;
constexpr size_t O_GLAP = O_RETS + 4194304;
constexpr size_t O_GLAS = O_GLAP + 1048576;
constexpr size_t O_CONVP = O_GLAS + 1048576;
constexpr size_t O_CONVS = O_CONVP + 180224;
constexpr size_t O_END = O_CONVS + 180224;

constexpr size_t WS_ROT = 16384;
constexpr size_t WS_WRI = WS_ROT + (size_t)8192 * 128 * 8;
constexpr size_t WS_WRO = WS_WRI + (size_t)RET_N * 1024 * 2;
constexpr size_t WS_WGI = WS_WRO + (size_t)1024 * 2048 * 2;
constexpr size_t WS_WGO = WS_WGI + (size_t)GLA_N * 1024 * 2;
constexpr size_t WS_WUP = WS_WGO + (size_t)1024 * 1024 * 2;
constexpr size_t WS_WDN = WS_WUP + (size_t)2 * FF2 * 1024 * 2;
constexpr size_t WS_H = WS_WDN + (size_t)2 * 1024 * FF * 2;
constexpr size_t WS_HALO = WS_H + (size_t)MT_ * DM * 2;
constexpr size_t WS_EB = WS_HALO + (size_t)2048 * 2 * FF * 2;
constexpr size_t WS_BIG = WS_EB + (size_t)NCHUNK * 512 * 4;
constexpr size_t WS_LG = WS_BIG + (size_t)MT_ * GLA_NB * 2;
constexpr size_t WS_TMP = WS_HALO;
constexpr size_t WS_SS = WS_TMP + (size_t)3 * MS * DM * 4;
constexpr size_t WS_SSP = WS_SS + (size_t)3 * MT_ * 4 + 256;
constexpr size_t WS_ACT = WS_BIG;
constexpr int NBLK = MT_ / 32;
constexpr size_t WS_HEAD = WS_BIG + (size_t)MT_ * FF * 2;
constexpr size_t WS_EDGE = WS_HEAD + (size_t)NBLK * 2 * FF2 * 2;
constexpr size_t WS_USLAB = WS_EDGE + (size_t)NBLK * 2 * FF2 * 2;
constexpr size_t WS_END = WS_BIG + (size_t)MT_ * RET_N * 2;
static_assert(WS_USLAB + (size_t)4 * MS * FF2 * 4 <= WS_END, "FFN side buffers must fit inside BIG");
static_assert(WS_SSP + (size_t)MT_ * 16 * 4 <= WS_EB, "halo slot overflow");

__device__ __forceinline__ unsigned pk(float lo, float hi) { f32x2 v = {lo, hi}; bf16v2 r = __builtin_convertvector(v, bf16v2); return __builtin_bit_cast(unsigned, r); }
__device__ __forceinline__ float bf_lo(unsigned w) { return __uint_as_float(w << 16); }
__device__ __forceinline__ float bf_hi(unsigned w) { return __uint_as_float(w & 0xffff0000u); }
__device__ __forceinline__ f32x4 bf4(u32x2 w) { return (f32x4){bf_lo(w.x), bf_hi(w.x), bf_lo(w.y), bf_hi(w.y)}; }
__device__ __forceinline__ float silu(float x) { return x * __builtin_amdgcn_rcpf(1.0f + __expf(-x)); }
__device__ __forceinline__ int tidx() { int t = threadIdx.x; asm volatile("" : "+v"(t)); return t; }
__device__ __forceinline__ int bidx() { int t = blockIdx.x; asm volatile("" : "+s"(t)); return t; }
#define MFMA16(a, b, c) __builtin_amdgcn_mfma_f32_16x16x32_bf16((a), (b), (c), 0, 0, 0)

#define XB_TMO      128
#define XB_XCNT(j)  (256  + 64 * (j))
#define XB_XSUB(j)  (1280 + 64 * (j))
#define XB_XGEN(j)  (2304 + 64 * (j))
#define XB_TOP      3328
#define XB_TOPGEN   3392
#define XCD_BAR_WORDS 3456
#define XB_SPIN_CAP (1u << 22)
__device__ __forceinline__ unsigned xb_ld(unsigned* p)              { return __hip_atomic_load(p, __ATOMIC_RELAXED, __HIP_MEMORY_SCOPE_AGENT); }
__device__ __forceinline__ unsigned xb_add(unsigned* p, unsigned v) { return __hip_atomic_fetch_add(p, v, __ATOMIC_RELAXED, __HIP_MEMORY_SCOPE_AGENT); }
__device__ __forceinline__ unsigned xb_xcc_id() { return (unsigned)__builtin_amdgcn_s_getreg((3 << 11) | 20) & 0xFu; }
#define XB_SPIN(cond, bar) do { unsigned _sp = 0; while (cond) { __builtin_amdgcn_s_sleep(1); \
    if ((++_sp & 255u) == 0u) { if (xb_ld(&(bar)[XB_TMO])) break; if (_sp > XB_SPIN_CAP) { atomicAdd(&(bar)[XB_TMO], 1u); break; } } } } while (0)
struct XcdBarrier { unsigned* bar; unsigned x; volatile LAS unsigned* st; };
__device__ __forceinline__ XcdBarrier xcd_barrier_post(unsigned* bar, volatile LAS unsigned* st) {
    XcdBarrier b; b.bar = bar; b.x = xb_xcc_id(); b.st = st;
    if (threadIdx.x == 0) (void)xb_add(&bar[XB_XCNT(b.x)], 1u);
    return b;
}
__device__ __forceinline__ void xcd_barrier_complete(unsigned* bar, unsigned x, unsigned& nloc, unsigned& nx) {
    const unsigned G = gridDim.x * gridDim.y * gridDim.z;
    unsigned sum, cnt, mine, sp = 0u;
    for (;;) {
        sum = 0u; cnt = 0u; mine = 0u;
#pragma unroll
        for (unsigned j = 0; j < 16; ++j) { const unsigned c = xb_ld(&bar[XB_XCNT(j)]); sum += c; cnt += (c > 0u) ? 1u : 0u; mine = (j == x) ? c : mine; }
        if (sum == G) break;
        __builtin_amdgcn_s_sleep(1);
        if ((++sp & 255u) == 0u) { if (xb_ld(&bar[XB_TMO])) break; if (sp > XB_SPIN_CAP) { atomicAdd(&bar[XB_TMO], 1u); break; } }
    }
    nloc = mine > 0u ? mine : 1u; nx = cnt > 0u ? cnt : 1u;
}
__device__ __forceinline__ void xcd_barrier(const XcdBarrier& b) {
    asm volatile("s_waitcnt vmcnt(0)" ::: "memory");
    __syncthreads();
    if (threadIdx.x == 0) {
        unsigned* bar = b.bar;
        __builtin_amdgcn_s_waitcnt(0);
        unsigned nloc = b.st[0], nx = b.st[1];
        if (nloc == 0u) { xcd_barrier_complete(bar, b.x, nloc, nx); b.st[0] = nloc; b.st[1] = nx; }
        const unsigned old = xb_add(&bar[XB_XSUB(b.x)], 1u);
        const unsigned gen = old / nloc;
        if (old + 1u == (gen + 1u) * nloc) {
            __builtin_amdgcn_fence(__ATOMIC_RELEASE, "agent");
            asm volatile("s_waitcnt vmcnt(0)" ::: "memory");
            const unsigned og = xb_add(&bar[XB_TOP], 1u);
            const unsigned tg = og / nx;
            if (og + 1u == (tg + 1u) * nx) xb_add(&bar[XB_TOPGEN], 1u);
            else XB_SPIN(xb_ld(&bar[XB_TOPGEN]) == tg, bar);
            __builtin_amdgcn_fence(__ATOMIC_ACQUIRE, "agent");
            xb_add(&bar[XB_XGEN(b.x)], 1u);
            asm volatile("s_waitcnt vmcnt(0)" ::: "memory");
        } else {
            XB_SPIN(xb_ld(&bar[XB_XGEN(b.x)]) == gen, bar);
            __builtin_amdgcn_fence(__ATOMIC_ACQUIRE, "agent");
            asm volatile("s_waitcnt vmcnt(0)" ::: "memory");
        }
    }
    __syncthreads();
}

struct Args {
    const float* in[20];
    float* out; unsigned char* ws;
    int ph_lo, ph_hi;
};

namespace pg8 {
constexpr int BM = 256, BK = 64, HALF = 128, HTB = HALF * BK * 2, STAGE_BYTES = 8 * HTB, NXCD = 8, WGM = 8;
__host__ __device__ __forceinline__ int lds_byte(int r, int c) { const int st = (r >> 4) * 2 + (c >> 5), rr = r & 15, cc = c & 31, ob = rr * 64 + cc * 2; return st * 1024 + (ob ^ (((ob >> 9) & 1) << 5)); }
__host__ __device__ __forceinline__ void stage_rc(int b, int& R, int& C) { const int st = b / 1024, sb = b % 1024, swz = sb ^ (((sb >> 9) & 1) << 5); R = (st >> 1) * 16 + swz / 64; C = (st & 1) * 32 + (swz % 64) / 2; }
__host__ __device__ __forceinline__ int perm32(int rho) { const int n = rho >> 4, i = rho & 15; return 8 * (i >> 2) + 4 * n + (i & 3); }
struct Unit { int pm, pn, kt0, nkt, split; };
struct Gemm { const bf16_t* A; const bf16_t* Bt; int M, N, K, lda; };
struct StaticOrder {
    int nM, nN, nwg, G, c, ntK, spl, npieces;
    __device__ __forceinline__ void init(int M, int N, int K, int G_, int c_, int spl_) { nM = M / BM; nN = N / BM; ntK = K / BK; spl = spl_; if (spl) { nM -= 1; npieces = nN * 4; } else npieces = 0; nwg = nM * nN; G = G_; c = c_; }
    __device__ __forceinline__ bool next(int i, Unit& u) const {
        const long L = (long)i * G + c;
        if (L >= nwg) { const int q = (int)(L - nwg); if (q >= npieces) return false; const int p = q / nN, half = ntK >> 1, b0 = (p * half) >> 2, b1 = ((p + 1) * half) >> 2;
            u.pm = nM; u.pn = q % nN; u.kt0 = 2 * b0; u.nkt = 2 * (b1 - b0); u.split = spl == 5 ? p + 1 : p; return true; }
        int wgid = (int)L; { const int q = nwg / NXCD, r = nwg % NXCD, xcd = wgid % NXCD, off = wgid / NXCD; wgid = (xcd < r ? xcd * (q + 1) : r * (q + 1) + (xcd - r) * q) + off; }
        const int nig = WGM * nN, gid = wgid / nig, fm = gid * WGM, gsz = (nM - fm) < WGM ? (nM - fm) : WGM;
        u.pm = fm + ((wgid % nig) % gsz); u.pn = (wgid % nig) / gsz; u.kt0 = 0; u.nkt = ntK; u.split = 0; return true;
    }
};

template <class Epi>
__device__ __forceinline__ void gemm_phase(LAS unsigned char* lds, const Gemm g, const StaticOrder& S, const Epi& E) {
    const int tid = tidx(), wid = __builtin_amdgcn_readfirstlane(tid >> 6), lane = tid & 63, wr = wid >> 2, wc = wid & 3, fr = lane & 15, fq = lane >> 4;
    const int K = g.K, lda = g.lda;
    unsigned voffA[2], voffB[2];
#pragma unroll
    for (int i = 0; i < 2; ++i) { int R, C; stage_rc(tid * 16 + i * 8192, R, C); const int Rb = (R & ~31) + perm32(R & 31);
        voffA[i] = (unsigned)(R * lda + C) * 2u; voffB[i] = (unsigned)(Rb * K + C) * 2u; }
    const size_t kstep = (size_t)(BK * 2);
    const size_t hstepA = (size_t)HALF * lda * 2, hstepB = (size_t)HALF * K * 2;
    const size_t tstepA = 2 * hstepA, tstepB = 2 * hstepB;
    const unsigned ldsw = (unsigned)wid * 1024u;
    const int aoff = lds_byte(wr * 64 + fr, fq * 8), boff = lds_byte(wc * 32 + fr, fq * 8);
#define PG8_SA(b, h) (((b) * 2 + (h)) * HTB)
#define PG8_SB(b, h) ((4 + (b) * 2 + (h)) * HTB)
#define PG8_STAGE(bufoff, gbase, voff) do { _Pragma("unroll") for (int _i = 0; _i < 2; ++_i) \
        __builtin_amdgcn_global_load_lds((const unsigned*)((const char*)(gbase) + (voff)[_i]), (LAS unsigned*)(lds + (bufoff) + ldsw + _i * 8192), 16, 0, 0); } while (0)
#define PG8_LDA(dst, b, h) do { _Pragma("unroll") for (int m = 0; m < 4; ++m) _Pragma("unroll") for (int k = 0; k < 2; ++k) dst[m][k] = *(const LAS bf16x8*)(lds + PG8_SA(b, h) + aoff + m * 2048 + k * 1024); } while (0)
#define PG8_LDB(dst, b, h) do { _Pragma("unroll") for (int n = 0; n < 2; ++n) _Pragma("unroll") for (int k = 0; k < 2; ++k) dst[n][k] = *(const LAS bf16x8*)(lds + PG8_SB(b, h) + boff + n * 2048 + k * 1024); } while (0)
#define PG8_MMA(ai, bj, At, Bt) do { __builtin_amdgcn_s_setprio(1); _Pragma("unroll") for (int m = 0; m < 4; ++m) _Pragma("unroll") for (int n = 0; n < 2; ++n) _Pragma("unroll") for (int k = 0; k < 2; ++k) \
        acc[ai][bj][m][n] = __builtin_amdgcn_mfma_f32_16x16x32_bf16(Bt[n][k], At[m][k], acc[ai][bj][m][n], 0, 0, 0); __builtin_amdgcn_s_setprio(0); } while (0)
#define PG8_WAIT_V(n) asm volatile("s_waitcnt vmcnt(" #n ")" ::: "memory")
#define PG8_WAIT_L(n) asm volatile("s_waitcnt lgkmcnt(" #n ")" ::: "memory")
#define PG8_BAR __builtin_amdgcn_s_barrier()
#define PG8_SCHED __builtin_amdgcn_sched_barrier(0)
    Unit cur, nxt; int ui = 0;
    if (!S.next(0, cur)) return;
    f32x4 acc[2][2][4][2];
#pragma unroll
    for (int a = 0; a < 2; ++a)
#pragma unroll
        for (int b = 0; b < 2; ++b)
#pragma unroll
            for (int m = 0; m < 4; ++m)
#pragma unroll
                for (int n = 0; n < 2; ++n) acc[a][b][m][n] = (f32x4){0.f, 0.f, 0.f, 0.f};
    bf16x8 At[4][2], B0[2][2], B1[2][2];
    const char* cA = (const char*)g.A + (size_t)cur.pm * tstepA + (size_t)cur.kt0 * kstep; const char* cB = (const char*)g.Bt + (size_t)cur.pn * tstepB + (size_t)cur.kt0 * kstep;
    if constexpr (Epi::LOOKAHEAD) E.fetch(lds, cur.pn, cur.pm, 0, wid, lane);
    PG8_STAGE(PG8_SB(0, 0), cB, voffB); PG8_STAGE(PG8_SA(0, 0), cA, voffA); PG8_STAGE(PG8_SB(0, 1), cB + hstepB, voffB); PG8_STAGE(PG8_SA(0, 1), cA + hstepA, voffA);
    if (wr == 1) PG8_BAR;
    PG8_WAIT_V(4); PG8_BAR;
    PG8_STAGE(PG8_SB(1, 0), cB + kstep, voffB); PG8_STAGE(PG8_SA(1, 0), cA + kstep, voffA); PG8_STAGE(PG8_SB(1, 1), cB + hstepB + kstep, voffB);
    PG8_WAIT_V(6); PG8_BAR;
    for (;;) {
        const bool has_next = S.next(ui + 1, nxt);
        const char* nA = has_next ? (const char*)g.A + (size_t)nxt.pm * tstepA + (size_t)nxt.kt0 * kstep : cA; const char* nB = has_next ? (const char*)g.Bt + (size_t)nxt.pn * tstepB + (size_t)nxt.kt0 * kstep : cB;
        const int nt = cur.nkt;
        for (int t = 0; t < nt; t += 2) {
            const bool last = (t == nt - 2);
            const char* a1 = cA + (size_t)(t + 1) * kstep;
            const char* a2 = last ? nA : cA + (size_t)(t + 2) * kstep; const char* b2 = last ? nB : cB + (size_t)(t + 2) * kstep;
            const char* a3 = a2 + kstep; const char* b3 = b2 + kstep;
            PG8_LDB(B0, 0, 0); PG8_SCHED; PG8_LDA(At, 0, 0); PG8_STAGE(PG8_SA(1, 1), a1 + hstepA, voffA);
            PG8_WAIT_L(8); PG8_BAR; PG8_WAIT_L(0); PG8_MMA(0, 0, At, B0); PG8_BAR; PG8_SCHED;
            PG8_LDB(B1, 0, 1); PG8_STAGE(PG8_SB(0, 0), b2, voffB);
            PG8_BAR; PG8_WAIT_L(0); PG8_MMA(0, 1, At, B1); PG8_BAR;
            PG8_LDA(At, 0, 1); PG8_STAGE(PG8_SA(0, 0), a2, voffA);
            PG8_BAR; PG8_WAIT_L(0); PG8_MMA(1, 0, At, B0); PG8_BAR; PG8_SCHED;
            PG8_STAGE(PG8_SB(0, 1), b2 + hstepB, voffB);
            PG8_WAIT_V(6); PG8_BAR; PG8_MMA(1, 1, At, B1); PG8_BAR;
            PG8_LDB(B0, 1, 0); PG8_SCHED; PG8_LDA(At, 1, 0); PG8_STAGE(PG8_SA(0, 1), a2 + hstepA, voffA);
            PG8_WAIT_L(8); PG8_BAR; PG8_WAIT_L(0); PG8_MMA(0, 0, At, B0); PG8_BAR; PG8_SCHED;
            PG8_LDB(B1, 1, 1); PG8_STAGE(PG8_SB(1, 0), b3, voffB);
            PG8_BAR; PG8_WAIT_L(0); PG8_MMA(0, 1, At, B1); PG8_BAR;
            PG8_LDA(At, 1, 1); PG8_STAGE(PG8_SA(1, 0), a3, voffA);
            PG8_BAR; PG8_WAIT_L(0); PG8_MMA(1, 0, At, B0); PG8_BAR; PG8_SCHED;
            PG8_STAGE(PG8_SB(1, 1), b3 + hstepB, voffB);
            PG8_WAIT_V(6); PG8_BAR; PG8_MMA(1, 1, At, B1); PG8_BAR;
        }
        if constexpr (Epi::LOOKAHEAD) E.ep(acc, cur, (has_next && nxt.split == 0) ? nxt.pn : -1, has_next ? nxt.pm : 0, ui, lds, wr, wc, fr, fq); else E(acc, cur, wr, wc, fr, fq);
        if (!has_next) break;
#pragma unroll
        for (int a = 0; a < 2; ++a)
#pragma unroll
            for (int b = 0; b < 2; ++b)
#pragma unroll
                for (int m = 0; m < 4; ++m)
#pragma unroll
                    for (int n = 0; n < 2; ++n) acc[a][b][m][n] = (f32x4){0.f, 0.f, 0.f, 0.f};
        cur = nxt; cA = nA; cB = nB; ++ui;
    }
    PG8_WAIT_V(0);
    if (wr == 0) PG8_BAR;
    PG8_BAR;
#undef PG8_SA
#undef PG8_SB
#undef PG8_STAGE
#undef PG8_LDA
#undef PG8_LDB
#undef PG8_MMA
#undef PG8_WAIT_V
#undef PG8_WAIT_L
#undef PG8_BAR
#undef PG8_SCHED
}
}

template <int MODE> struct Epi {
    static constexpr bool LOOKAHEAD = false;
    bf16_t* O; int ldc;
    const f32x2* rot;
    const float* resP; const float* resS; float* tmp;
    bf16_t* lg; const float* b_a;
    bf16_t* xb; float* ssw;
    const float* ssr;
    __device__ __forceinline__ void operator()(const f32x4 (&acc)[2][2][4][2], const pg8::Unit& u, int wr, int wc, int fr, int fq) const {
        const int row0 = u.pm * 256 + wr * 64 + fr;
        const int colt = u.pn * 256 + wc * 32 + 8 * fq;
        if (MODE == 1 && u.pn < 8) {
            const int hh = u.pn & 3; const bool isq = u.pn < 4;
            const float lgam = hh == 0 ? -0.031748698314580f : hh == 1 ? -0.015748356968139f : hh == 2 ? -0.007843177461025f : -0.003913899321136f;
            const int d0 = wc * 32 + 8 * fq;
#pragma unroll
            for (int ai = 0; ai < 2; ++ai)
#pragma unroll
                for (int m = 0; m < 4; ++m) {
                    const int r = row0 + ai * 128 + m * 16;
                    int pos, ci;
                    if (r < MP) { pos = r & (SEQ - 1); ci = pos & 63; } else { const int t = (r - MP) & (DSEQ - 1); pos = PAST + t; ci = t; }
                    const float e = (float)(ci + 1) * lgam; const float f = __expf(isq ? e : -e);
                    const f32x4* tp = (const f32x4*)(rot + (size_t)pos * 128 + d0);
                    const f32x4 t0 = tp[0], t1 = tp[1], t2 = tp[2], t3 = tp[3];
                    const f32x4 a0 = acc[ai][0][m][0], a1 = acc[ai][0][m][1], b0 = acc[ai][1][m][0], b1 = acc[ai][1][m][1];
                    f32x4 y0, y1, z0, z1;
                    y0[0] = (a0[0] * t0[0] - b0[0] * t0[1]) * f; z0[0] = (a0[0] * t0[1] + b0[0] * t0[0]) * f;
                    y0[1] = (a0[1] * t0[2] - b0[1] * t0[3]) * f; z0[1] = (a0[1] * t0[3] + b0[1] * t0[2]) * f;
                    y0[2] = (a0[2] * t1[0] - b0[2] * t1[1]) * f; z0[2] = (a0[2] * t1[1] + b0[2] * t1[0]) * f;
                    y0[3] = (a0[3] * t1[2] - b0[3] * t1[3]) * f; z0[3] = (a0[3] * t1[3] + b0[3] * t1[2]) * f;
                    y1[0] = (a1[0] * t2[0] - b1[0] * t2[1]) * f; z1[0] = (a1[0] * t2[1] + b1[0] * t2[0]) * f;
                    y1[1] = (a1[1] * t2[2] - b1[1] * t2[3]) * f; z1[1] = (a1[1] * t2[3] + b1[1] * t2[2]) * f;
                    y1[2] = (a1[2] * t3[0] - b1[2] * t3[1]) * f; z1[2] = (a1[2] * t3[1] + b1[2] * t3[0]) * f;
                    y1[3] = (a1[3] * t3[2] - b1[3] * t3[3]) * f; z1[3] = (a1[3] * t3[3] + b1[3] * t3[2]) * f;
                    bf16_t* rowp = O + (size_t)r * ldc + colt;
                    u32x4 w; w.x = pk(y0[0], y0[1]); w.y = pk(y0[2], y0[3]); w.z = pk(y1[0], y1[1]); w.w = pk(y1[2], y1[3]);
                    *(u32x4*)(rowp) = w;
                    w.x = pk(z0[0], z0[1]); w.y = pk(z0[2], z0[3]); w.z = pk(z1[0], z1[1]); w.w = pk(z1[2], z1[3]);
                    *(u32x4*)(rowp + 128) = w;
                }
            return;
        }
        if (MODE == 3 && u.pn >= 12) {
            if (wc == 0 && fq < 2) {
#pragma unroll
                for (int ai = 0; ai < 2; ++ai)
#pragma unroll
                    for (int m = 0; m < 4; ++m) {
                        const int r = row0 + ai * 128 + m * 16;
                        const float rs = rsqrtf(ssr[r] * (1.0f / DM) + EPS);
                        const f32x4 v0 = acc[ai][0][m][0] * rs, v1 = acc[ai][0][m][1] * rs;
                        u32x4 w; w.x = pk(v0[0], v0[1]); w.y = pk(v0[2], v0[3]); w.z = pk(v1[0], v1[1]); w.w = pk(v1[2], v1[3]);
                        *(u32x4*)(lg + (size_t)r * 16 + 8 * fq) = w;
                    }
            }
            return;
        }
        if (MODE == 2) {
#pragma unroll
            for (int ai = 0; ai < 2; ++ai)
#pragma unroll
                for (int m = 0; m < 4; ++m) {
                    const int r = row0 + ai * 128 + m * 16;
                    if (u.split) {
                        float* tp = tmp + ((size_t)(u.split - 1) * MS + (r - MP)) * DM + colt;
#pragma unroll
                        for (int bj = 0; bj < 2; ++bj)
#pragma unroll
                            for (int n = 0; n < 2; ++n) *(f32x4*)(tp + bj * 128 + 4 * n) = acc[ai][bj][m][n];
                        continue;
                    }
                    bf16_t* xp = xb + (size_t)r * DM + colt;
                    const float* rp = resP ? (r < MP ? resP + (size_t)r * DM : resS + (size_t)(r - MP) * DM) + colt : nullptr;
                    float sq = 0.f; const bool stat = ssw != nullptr && r < MP;
#pragma unroll
                    for (int bj = 0; bj < 2; ++bj) {
                        f32x4 r0, r1;
                        if (resP) { r0 = *(const f32x4*)(rp + bj * 128); r1 = *(const f32x4*)(rp + bj * 128 + 4); }
                        else { const u32x4 w = *(const u32x4*)(xp + bj * 128); r0 = (f32x4){bf_lo(w.x), bf_hi(w.x), bf_lo(w.y), bf_hi(w.y)}; r1 = (f32x4){bf_lo(w.z), bf_hi(w.z), bf_lo(w.w), bf_hi(w.w)}; }
                        const f32x4 v0 = r0 + acc[ai][bj][m][0], v1 = r1 + acc[ai][bj][m][1];
                        u32x4 w; w.x = pk(v0[0], v0[1]); w.y = pk(v0[2], v0[3]); w.z = pk(v1[0], v1[1]); w.w = pk(v1[2], v1[3]); *(u32x4*)(xp + bj * 128) = w;
                        if (stat) sq += (v0[0] * v0[0] + v0[1] * v0[1]) + (v0[2] * v0[2] + v0[3] * v0[3]) + (v1[0] * v1[0] + v1[1] * v1[1]) + (v1[2] * v1[2] + v1[3] * v1[3]);
                    }
                    if (stat) { sq += __shfl_xor(sq, 16); sq += __shfl_xor(sq, 32); if (fq == 0) ssw[(size_t)r * 16 + u.pn * 4 + wc] = sq; }
                }
            return;
        }
#pragma unroll
        for (int ai = 0; ai < 2; ++ai)
#pragma unroll
            for (int m = 0; m < 4; ++m) {
                bf16_t* rowp = O + (size_t)(row0 + ai * 128 + m * 16) * ldc + colt;
                const float rs = MODE == 3 ? rsqrtf(ssr[row0 + ai * 128 + m * 16] * (1.0f / DM) + EPS) : 1.0f;
#pragma unroll
                for (int bj = 0; bj < 2; ++bj) {
                    const f32x4 v0 = acc[ai][bj][m][0] * rs, v1 = acc[ai][bj][m][1] * rs;
                    u32x4 w; w.x = pk(v0[0], v0[1]); w.y = pk(v0[2], v0[3]); w.z = pk(v1[0], v1[1]); w.w = pk(v1[2], v1[3]);
                    *(u32x4*)(rowp + bj * 128) = w;
                }
            }
    }
};


template <int CTRL> __device__ __forceinline__ float dpp_keep(float old, float x) { return __builtin_bit_cast(float, __builtin_amdgcn_update_dpp(__builtin_bit_cast(int, old), __builtin_bit_cast(int, x), CTRL, 0xf, 0xf, false)); }
template <int CTRL> __device__ __forceinline__ float dpp_zero(float x) { return __builtin_bit_cast(float, __builtin_amdgcn_update_dpp(0, __builtin_bit_cast(int, x), CTRL, 0xf, 0xf, true)); }
struct EpiConv {
    bf16_t* act; bf16_t* head; bf16_t* edge; const float* cw; const float* cb; float* uslab; const float* ss;
    static constexpr bool LOOKAHEAD = true;
    __device__ __forceinline__ void fetch(LAS unsigned char* lds, int pn, int pm, int slot, int wv_, int ln_) const {
        if (wv_ < 4) __builtin_amdgcn_global_load_lds((const unsigned*)(ss + 256 * pm + wv_ * 64 + ln_), (LAS unsigned*)((LAS float*)(lds + 131072) + (slot & 1) * 1280 + 1024 + wv_ * 64), 4, 0, 0);
#pragma unroll
        for (int hh = 0; hh < 2; ++hh) { const int e = hh * 512 + wv_ * 64 + ln_, prm = e >> 8, typ = (e >> 7) & 1, col = e & 127;
            __builtin_amdgcn_global_load_lds((const unsigned*)((prm < 3 ? cw + prm * FF2 : cb) + typ * FF + 128 * pn + col),
                                             (LAS unsigned*)((LAS float*)(lds + 131072) + (slot & 1) * 1280 + hh * 512 + wv_ * 64), 4, 0, 0); }
    }
    __device__ __forceinline__ void ep(const f32x4 (&acc)[2][2][4][2], const pg8::Unit& u, int npn, int npm, int ui, LAS unsigned char* lds, int wr, int wc, int fr, int fq) const {
        const int f0 = u.pn * 128 + wc * 32 + 8 * fq;
        LAS float* WLc = (LAS float*)(lds + 131072) + (ui & 1) * 1280;
        const bool donext = npn >= 0;
        if (donext && !u.split) fetch(lds, npn, npm, ui + 1, wr * 4 + wc, (fq << 4) + fr);
        const int fl = wc * 32 + 8 * fq;
        if (u.split) {
            float* sp = uslab + (size_t)(u.split - 1) * MS * FF2 + f0;
#pragma unroll
            for (int ai = 0; ai < 2; ++ai)
#pragma unroll
                for (int m = 0; m < 4; ++m) { float* rp = sp + (size_t)(ai * 128 + wr * 64 + m * 16 + fr) * FF2;
#pragma unroll
                    for (int n = 0; n < 2; ++n) { *(f32x4*)(rp + 4 * n) = acc[ai][0][m][n]; *(f32x4*)(rp + FF + 4 * n) = acc[ai][1][m][n]; } }
            return;
        }
#pragma unroll
        for (int n = 0; n < 2; ++n) {
            const int f = f0 + 4 * n;
#pragma unroll
            for (int ai = 0; ai < 2; ++ai)
#pragma unroll
                for (int mh = 0; mh < 2; ++mh) {
                    const int rowb = u.pm * 256 + ai * 128 + wr * 64 + mh * 32, blk = rowb >> 5;
                    f32x4 wg0, wg1, wg2, bg, wv0, wv1, wv2, bv;
                    { const LAS float* wl = WLc + fl + 4 * n;
                        wg0 = *(const LAS f32x4*)wl; wv0 = *(const LAS f32x4*)(wl + 128); wg1 = *(const LAS f32x4*)(wl + 256); wv1 = *(const LAS f32x4*)(wl + 384);
                        wg2 = *(const LAS f32x4*)(wl + 512); wv2 = *(const LAS f32x4*)(wl + 640); bg = *(const LAS f32x4*)(wl + 768); bv = *(const LAS f32x4*)(wl + 896); }
                    const int rl = ai * 128 + wr * 64 + mh * 32 + fr;
                    const float s0 = WLc[1024 + rl], s1 = WLc[1024 + rl + 16];
                    const float rs0 = rsqrtf(s0 * (1.0f / DM) + EPS), rs1 = rsqrtf(s1 * (1.0f / DM) + EPS);
                    const f32x4 xg0 = acc[ai][0][2 * mh][n] * rs0, xg1 = acc[ai][0][2 * mh + 1][n] * rs1, xv0 = acc[ai][1][2 * mh][n] * rs0, xv1 = acc[ai][1][2 * mh + 1][n] * rs1;
                    if (fr < 2 || fr >= 14) {
                        const bool isH = fr < 2;
                        const f32x4 sg = isH ? xg0 : xg1, sv = isH ? xv0 : xv1;
                        bf16_t* bp = (isH ? head : edge) + ((unsigned)(blk * 2 + (isH ? fr : fr - 14)) * (unsigned)FF2 + (unsigned)f);
                        u32x2 w; w.x = pk(sg[0], sg[1]); w.y = pk(sg[2], sg[3]); *(u32x2*)bp = w; w.x = pk(sv[0], sv[1]); w.y = pk(sv[2], sv[3]); *(u32x2*)(bp + FF) = w; }
                    f32x4 a0, a1;
                    f32x4 cg = bg + xg0 * wg2, cv = bv + xv0 * wv2, dg = bg + xg1 * wg2, dv = bv + xv1 * wv2;
#pragma unroll
                    for (int j = 0; j < 4; ++j) {
                        float c0 = cg[j], c1 = cv[j], d0 = dg[j], d1 = dv[j];
                        asm volatile("s_nop 4\n\t"
                                     "v_fmac_f32_dpp %0, %4, %8 row_shr:1 row_mask:0xf bank_mask:0xf bound_ctrl:1\n\t"
                                     "v_fmac_f32_dpp %0, %4, %9 row_shr:2 row_mask:0xf bank_mask:0xf bound_ctrl:1\n\t"
                                     "v_fmac_f32_dpp %1, %5, %10 row_shr:1 row_mask:0xf bank_mask:0xf bound_ctrl:1\n\t"
                                     "v_fmac_f32_dpp %1, %5, %11 row_shr:2 row_mask:0xf bank_mask:0xf bound_ctrl:1\n\t"
                                     "v_fmac_f32_dpp %2, %6, %8 row_shr:1 row_mask:0xf bank_mask:0xf bound_ctrl:1\n\t"
                                     "v_fmac_f32_dpp %2, %6, %9 row_shr:2 row_mask:0xf bank_mask:0xf bound_ctrl:1\n\t"
                                     "v_fmac_f32_dpp %2, %4, %8 row_shl:15 row_mask:0xf bank_mask:0xf bound_ctrl:1\n\t"
                                     "v_fmac_f32_dpp %2, %4, %9 row_shl:14 row_mask:0xf bank_mask:0xf bound_ctrl:1\n\t"
                                     "v_fmac_f32_dpp %3, %7, %10 row_shr:1 row_mask:0xf bank_mask:0xf bound_ctrl:1\n\t"
                                     "v_fmac_f32_dpp %3, %7, %11 row_shr:2 row_mask:0xf bank_mask:0xf bound_ctrl:1\n\t"
                                     "v_fmac_f32_dpp %3, %5, %10 row_shl:15 row_mask:0xf bank_mask:0xf bound_ctrl:1\n\t"
                                     "v_fmac_f32_dpp %3, %5, %11 row_shl:14 row_mask:0xf bank_mask:0xf bound_ctrl:1"
                                     : "+v"(c0), "+v"(c1), "+v"(d0), "+v"(d1)
                                     : "v"(xg0[j]), "v"(xv0[j]), "v"(xg1[j]), "v"(xv1[j]), "v"(wg1[j]), "v"(wg0[j]), "v"(wv1[j]), "v"(wv0[j]));
                        a0[j] = silu(c0) * c1; a1[j] = silu(d0) * d1;
                    }
                    u32x2 w;
                    if (fr >= 2) { w.x = pk(a0[0], a0[1]); w.y = pk(a0[2], a0[3]); *(u32x2*)(act + (size_t)(rowb + fr) * FF + f) = w; }
                    w.x = pk(a1[0], a1[1]); w.y = pk(a1[2], a1[3]); *(u32x2*)(act + (size_t)(rowb + 16 + fr) * FF + f) = w;
                    __builtin_amdgcn_sched_barrier(0);
                }
        }
    }
};
__device__ __forceinline__ void convfix_phase(bf16_t* act, const bf16_t* head, const bf16_t* edge, const float* cw, const float* cb, const float* cache, float* convP, float* convS, const float* uslab, const float* ss) {
    const int gtid = bidx() * 512 + tidx(), gthreads = gridDim.x * 512;
    for (int i = gtid; i < (MP / 32) * 2 * (FF / 4); i += gthreads) {
        const int c = 4 * (i % (FF / 4)), jj = (i / (FF / 4)) & 1, B = i / (2 * (FF / 4));
        const bool samp = B >= MP / 32, first = samp || (B & 255) == 0;
        const f32x4 wg0 = *(const f32x4*)(cw + c), wg1 = *(const f32x4*)(cw + FF2 + c), wg2 = *(const f32x4*)(cw + 2 * FF2 + c), bg = *(const f32x4*)(cb + c);
        const f32x4 wv0 = *(const f32x4*)(cw + FF + c), wv1 = *(const f32x4*)(cw + FF2 + FF + c), wv2 = *(const f32x4*)(cw + 2 * FF2 + FF + c), bv = *(const f32x4*)(cb + FF + c);
        const bf16_t* hp = head + ((size_t)B * 2 + jj) * FF2 + c;
        const f32x4 xg = bf4(*(const u32x2*)hp), xv = bf4(*(const u32x2*)(hp + FF));
        f32x4 e0g, e0v, e1g, e1v;
        if (!first) { const bf16_t* ep = edge + ((size_t)(B - 1) * 2) * FF2 + c; e0g = bf4(*(const u32x2*)ep); e0v = bf4(*(const u32x2*)(ep + FF)); e1g = bf4(*(const u32x2*)(ep + FF2)); e1v = bf4(*(const u32x2*)(ep + FF2 + FF)); }
        else if (samp) { const float* cs = cache + (size_t)(B - MP / 32) * 2 * FF2 + c; e0g = *(const f32x4*)cs; e0v = *(const f32x4*)(cs + FF); e1g = *(const f32x4*)(cs + FF2); e1v = *(const f32x4*)(cs + FF2 + FF); }
        else { e0g = e0v = e1g = e1v = (f32x4){0.f, 0.f, 0.f, 0.f}; }
        f32x4 p2g, p2v, p1g, p1v;
        if (jj == 0) { p2g = e0g; p2v = e0v; p1g = e1g; p1v = e1v; }
        else { p2g = e1g; p2v = e1v; const bf16_t* h0 = head + ((size_t)B * 2) * FF2 + c; p1g = bf4(*(const u32x2*)h0); p1v = bf4(*(const u32x2*)(h0 + FF)); }
        const f32x4 cg = bg + p2g * wg0 + p1g * wg1 + xg * wg2, cv = bv + p2v * wv0 + p1v * wv1 + xv * wv2;
        u32x2 w; w.x = pk(silu(cg[0]) * cv[0], silu(cg[1]) * cv[1]); w.y = pk(silu(cg[2]) * cv[2], silu(cg[3]) * cv[3]);
        *(u32x2*)(act + (size_t)(32 * B + jj) * FF + c) = w;
    }
    for (int i = gtid; i < MS * (FF / 4); i += gthreads) {
        const int c = 4 * (i % (FF / 4)), r = i / (FF / 4), t = r & 31, b = r >> 5;
        const f32x4 wg0 = *(const f32x4*)(cw + c), wg1 = *(const f32x4*)(cw + FF2 + c), wg2 = *(const f32x4*)(cw + 2 * FF2 + c), bg = *(const f32x4*)(cb + c);
        const f32x4 wv0 = *(const f32x4*)(cw + FF + c), wv1 = *(const f32x4*)(cw + FF2 + FF + c), wv2 = *(const f32x4*)(cw + 2 * FF2 + FF + c), bv = *(const f32x4*)(cb + FF + c);
        f32x4 xg[3], xv[3];
#pragma unroll
        for (int k = 0; k < 3; ++k) { const int tt = t - 2 + k;
            if (tt < 0) { const float* cs = cache + ((size_t)b * 2 + (tt + 2)) * FF2 + c; xg[k] = *(const f32x4*)cs; xv[k] = *(const f32x4*)(cs + FF); }
            else { const float* sp = uslab + (size_t)(r - 2 + k) * FF2 + c; xg[k] = (f32x4){0.f, 0.f, 0.f, 0.f}; xv[k] = xg[k];
#pragma unroll
                for (int p4 = 0; p4 < 4; ++p4) { xg[k] += *(const f32x4*)(sp + (size_t)p4 * MS * FF2); xv[k] += *(const f32x4*)(sp + (size_t)p4 * MS * FF2 + FF); }
                const float rs = rsqrtf(ss[MP + r - 2 + k] * (1.0f / DM) + EPS); xg[k] *= rs; xv[k] *= rs; } }
        const f32x4 cg = bg + xg[0] * wg0 + xg[1] * wg1 + xg[2] * wg2, cv = bv + xv[0] * wv0 + xv[1] * wv1 + xv[2] * wv2;
        u32x2 w; w.x = pk(silu(cg[0]) * cv[0], silu(cg[1]) * cv[1]); w.y = pk(silu(cg[2]) * cv[2], silu(cg[3]) * cv[3]);
        *(u32x2*)(act + (size_t)(MP + r) * FF + c) = w;
        if (t >= 30) { float* dst = convS + ((size_t)b * 2 + (t - 30)) * FF2 + c; *(f32x4*)dst = xg[2]; *(f32x4*)(dst + FF) = xv[2]; }
    }
    for (int i = gtid; i < 8 * 2 * (FF2 / 4); i += gthreads) {
        const int c = 4 * (i % (FF2 / 4)), jj = (i / (FF2 / 4)) & 1, sq = i / (2 * (FF2 / 4));
        const int B = sq * 256 + 255;
        *(f32x4*)(convP + ((size_t)sq * 2 + jj) * FF2 + c) = bf4(*(const u32x2*)(edge + ((size_t)B * 2 + jj) * FF2 + c));
    }
}

__device__ __forceinline__ void norm_phase(const float* xP, float* xS, const float* g, bf16_t* h, const float* tmp) {
    const int tid_ = tidx(), lane = tid_ & 63, wv = bidx() * 8 + (tid_ >> 6), nw = gridDim.x * 8;
    f32x4 gv[4];
#pragma unroll
    for (int i = 0; i < 4; ++i) gv[i] = *(const f32x4*)(g + (i * 64 + lane) * 4);
    for (int r0 = wv; r0 < MT_; r0 += 4 * nw) {
        f32x4 v[4][4];
#pragma unroll
        for (int u = 0; u < 4; ++u) { const int r = r0 + u * nw; if (r < MT_) { const float* xp = r < MP ? xP + (size_t)r * DM : xS + (size_t)(r - MP) * DM;
#pragma unroll
            for (int i = 0; i < 4; ++i) v[u][i] = *(const f32x4*)(xp + (i * 64 + lane) * 4);
            if (tmp && r >= MP) {
#pragma unroll
                for (int i = 0; i < 4; ++i) { const float* tp = tmp + (size_t)(r - MP) * DM + (i * 64 + lane) * 4;
                    v[u][i] += *(const f32x4*)tp + *(const f32x4*)(tp + (size_t)MS * DM) + *(const f32x4*)(tp + 2 * (size_t)MS * DM);
                    *(f32x4*)(xS + (size_t)(r - MP) * DM + (i * 64 + lane) * 4) = v[u][i]; } } } }
#pragma unroll
        for (int u = 0; u < 4; ++u) { const int r = r0 + u * nw; if (r < MT_) {
            float ss = 0.f;
#pragma unroll
            for (int i = 0; i < 4; ++i) ss += v[u][i][0] * v[u][i][0] + v[u][i][1] * v[u][i][1] + v[u][i][2] * v[u][i][2] + v[u][i][3] * v[u][i][3];
#pragma unroll
            for (int o = 32; o >= 1; o >>= 1) ss += __shfl_xor(ss, o);
            const float rs = rsqrtf(ss * (1.0f / DM) + EPS);
#pragma unroll
            for (int i = 0; i < 4; ++i) { u32x2 w; w.x = pk(v[u][i][0] * rs * gv[i][0], v[u][i][1] * rs * gv[i][1]); w.y = pk(v[u][i][2] * rs * gv[i][2], v[u][i][3] * rs * gv[i][3]);
                *(u32x2*)(h + (size_t)r * DM + (i * 64 + lane) * 4) = w; } } }
    }
}
__device__ __forceinline__ void samplenorm_phase(bf16_t* xS, float* ssS, const float* tmp, const float* ssp) {
    const int tid_ = tidx(), lane = tid_ & 63, wv = bidx() * 8 + (tid_ >> 6), nw = gridDim.x * 8;
    { const int gtid = bidx() * 512 + tid_, gthreads = gridDim.x * 512;
      for (int r = gtid; r < MP; r += gthreads) { const f32x4* pp = (const f32x4*)(ssp + (size_t)r * 16); const f32x4 a = pp[0], b = pp[1], c = pp[2], d = pp[3];
          (ssS - MP)[r] = ((a[0] + a[1]) + (a[2] + a[3])) + ((b[0] + b[1]) + (b[2] + b[3])) + ((c[0] + c[1]) + (c[2] + c[3])) + ((d[0] + d[1]) + (d[2] + d[3])); } }
    for (int r = wv; r < MS; r += nw) {
        float ss = 0.f;
#pragma unroll
        for (int i = 0; i < 4; ++i) { const size_t o = (size_t)r * DM + (i * 64 + lane) * 4; const float* tp = tmp + o;
            const f32x4 v = bf4(*(const u32x2*)(xS + o)) + *(const f32x4*)tp + *(const f32x4*)(tp + (size_t)MS * DM) + *(const f32x4*)(tp + 2 * (size_t)MS * DM);
            u32x2 w; w.x = pk(v[0], v[1]); w.y = pk(v[2], v[3]); *(u32x2*)(xS + o) = w;
            ss += (v[0] * v[0] + v[1] * v[1]) + (v[2] * v[2] + v[3] * v[3]); }
#pragma unroll
        for (int o = 32; o >= 1; o >>= 1) ss += __shfl_xor(ss, o);
        if (lane == 0) ssS[r] = ss;
    }
}
__device__ __forceinline__ void final_norm_phase(const bf16_t* xb, float* y, const float* g, int dry, const float* tmp) {
    const int tid_ = tidx(), lane = tid_ & 63, wv = bidx() * 8 + (tid_ >> 6), nw = gridDim.x * 8;
    f32x4 gv[4];
#pragma unroll
    for (int i = 0; i < 4; ++i) gv[i] = *(const f32x4*)(g + (i * 64 + lane) * 4);
    for (int r0 = wv; r0 < MT_; r0 += 4 * nw) {
        f32x4 v[4][4];
#pragma unroll
        for (int u = 0; u < 4; ++u) { const int r = r0 + u * nw; if (r < MT_) {
#pragma unroll
            for (int i = 0; i < 4; ++i) v[u][i] = bf4(*(const u32x2*)(xb + (size_t)r * DM + (i * 64 + lane) * 4));
            if (r >= MP) {
#pragma unroll
                for (int i = 0; i < 4; ++i) { const float* tp = tmp + (size_t)(r - MP) * DM + (i * 64 + lane) * 4;
                    v[u][i] += *(const f32x4*)tp + *(const f32x4*)(tp + (size_t)MS * DM) + *(const f32x4*)(tp + 2 * (size_t)MS * DM); } } } }
#pragma unroll
        for (int u = 0; u < 4; ++u) { const int r = r0 + u * nw; if (r < MT_) {
            float ss = 0.f;
#pragma unroll
            for (int i = 0; i < 4; ++i) ss += v[u][i][0] * v[u][i][0] + v[u][i][1] * v[u][i][1] + v[u][i][2] * v[u][i][2] + v[u][i][3] * v[u][i][3];
#pragma unroll
            for (int o = 32; o >= 1; o >>= 1) ss += __shfl_xor(ss, o);
            const float rs = rsqrtf(ss * (1.0f / DM) + EPS);
#pragma unroll
            for (int i = 0; i < 4; ++i) { const f32x4 yy = v[u][i] * rs * gv[i]; if (!dry) *(f32x4*)(y + (size_t)r * DM + (i * 64 + lane) * 4) = yy; } } }
    }
}

__device__ __forceinline__ void transpose_quad(LAS float* tile, const float* src, int ldsrc, int sc0, int sc1, int sc2, int sc3, bf16_t* dst, int K, int dstrow0, int tk, float scale, const float* gk = nullptr, int collim = 1 << 30) {
    const int tid_ = tidx(), tx = tid_ & 63, ty = tid_ >> 6;
    const int scol[4] = {sc0, sc1, sc2, sc3};
    float v[4][8];
#pragma unroll
    for (int sub = 0; sub < 4; ++sub)
#pragma unroll
        for (int i = 0; i < 8; ++i) v[sub][i] = (scol[sub] + tx < collim) ? src[(size_t)(tk * 64 + ty + 8 * i) * ldsrc + scol[sub] + tx] * (gk ? gk[tk * 64 + ty + 8 * i] : 1.0f) : 0.f;
#pragma unroll
    for (int sub = 0; sub < 4; ++sub)
#pragma unroll
        for (int i = 0; i < 8; ++i) tile[sub * 4160 + (ty + 8 * i) * 65 + tx] = v[sub][i];
    __syncthreads();
#pragma unroll
    for (int sub = 0; sub < 4; ++sub)
#pragma unroll
        for (int i = 0; i < 8; ++i) { const int nn = ty + 8 * i; dst[(size_t)(dstrow0 + 64 * sub + nn) * K + tk * 64 + tx] = (bf16_t)(pk(tile[sub * 4160 + tx * 65 + nn] * scale, 0.f) & 0xffffu); }
    __syncthreads();
}

__device__ __forceinline__ void weight_jobs(LAS unsigned char* lds, const Args& a, int set, int w, int nw) {
    unsigned char* ws = a.ws;
    LAS float* tile = (LAS float*)lds;
    const float* ret_w_in = a.in[8]; const float* ret_w_out = a.in[10]; const float* gla_w_in = a.in[11];
    const float* gla_w_out = a.in[15]; const float* ffn_w_up = a.in[16]; const float* ffn_w_down = a.in[19];
    const int T0 = 24 * 16, T1 = T0 + 4 * 32, T2 = T1 + 13 * 16, T3 = T2 + 4 * 16, T4 = T3 + 2 * 22 * 16, T5 = T4 + 2 * 4 * 44;
    const int U0 = T3 + 22 * 16, D0 = T4 + 4 * 44;
    const int njobs = set == 0 ? T0 : set == 1 ? (U0 - T0) + (D0 - T4) : (T4 - U0) + (T5 - D0);
    for (int jj = w; jj < njobs; jj += nw) {
        const int t = set == 0 ? jj : set == 1 ? (jj < U0 - T0 ? T0 + jj : T4 + (jj - (U0 - T0))) : (jj < T4 - U0 ? U0 + jj : D0 + (jj - (T4 - U0)));
        if (t < T0) { const int tq = t / 16, tk = t % 16, c = tq * 256; const float sc = (tq >= 4 && tq < 8) ? 0.0625f : 1.0f;
            transpose_quad(tile, ret_w_in, RET_N, c, c + 64, c + 128, c + 192, (bf16_t*)(ws + WS_WRI), 1024, c, tk, sc); }
        else if (t < T1) { const int q = t - T0, tq = q / 32, tk = q % 32, c = tq * 256; transpose_quad(tile, ret_w_out, 1024, c, c + 64, c + 128, c + 192, (bf16_t*)(ws + WS_WRO), 2048, c, tk, 1.0f); }
        else if (t < T2) { const int q = t - T1, tq = q / 16, tk = q % 16, c = tq * 256; const float sc = (tq >= 2 && tq < 4) ? 0.08838834764831845f : 1.0f;
            transpose_quad(tile, gla_w_in, 3088, c, c + 64, c + 128, c + 192, (bf16_t*)(ws + WS_WGI), 1024, c, tk, sc, a.in[5] + DM, 3088); }
        else if (t < T3) { const int q = t - T2, tq = q / 16, tk = q % 16, c = tq * 256; transpose_quad(tile, gla_w_out, 1024, c, c + 64, c + 128, c + 192, (bf16_t*)(ws + WS_WGO), 1024, c, tk, 1.0f); }
        else if (t < T4) { int q = t - T3; const int l = q / (22 * 16); q %= 22 * 16; const int tq = q / 16, tk = q % 16, g0 = 128 * tq;
            transpose_quad(tile, ffn_w_up + (size_t)l * 1024 * FF2, FF2, g0, g0 + 64, FF + g0, FF + g0 + 64, (bf16_t*)(ws + WS_WUP) + (size_t)l * FF2 * 1024, 1024, tq * 256, tk, 1.0f, a.in[6] + l * DM); }
        else { int q = t - T4; const int l = q / (4 * 44); q %= 4 * 44; const int tq = q / 44, tk = q % 44, c = tq * 256;
            transpose_quad(tile, ffn_w_down + (size_t)l * FF * 1024, 1024, c, c + 64, c + 128, c + 192, (bf16_t*)(ws + WS_WDN) + (size_t)l * 1024 * FF, FF, c, tk, 1.0f); }
    }
}

__device__ __forceinline__ void prep_phase(LAS unsigned char* lds, const Args& a) {
    unsigned char* ws = a.ws;
    LAS float* tile = (LAS float*)lds;
    const float* ret_w_in = a.in[8]; const float* ret_w_out = a.in[10]; const float* gla_w_in = a.in[11]; const float* gla_w_a2 = a.in[12];
    const float* gla_w_out = a.in[15]; const float* ffn_w_up = a.in[16]; const float* ffn_w_down = a.in[19];
    weight_jobs(lds, a, 0, bidx(), gridDim.x);
    const int gtid = bidx() * 512 + tidx(), gthreads = gridDim.x * 512;
    f32x2* rot = (f32x2*)(ws + WS_ROT);
    { const int d = gtid & 127; const double inv = exp(-(double)d * (9.210340371976184 / 128.0));
      for (int pos = gtid >> 7; pos < 8192; pos += gthreads >> 7) {
          const double ang = (double)pos * inv; const double red = ang - 6.283185307179586 * rint(ang * 0.15915494309189535);
          const float rf = (float)red; rot[pos * 128 + d] = (f32x2){cosf(rf), sinf(rf)}; } }
    for (int i = gtid; i < 3 * MT_; i += gthreads) ((float*)(ws + WS_SS))[i] = 0.f;
    norm_phase(a.in[0], (float*)a.in[1], a.in[5], (bf16_t*)(ws + WS_H), nullptr);
}

template <bool RET>
__device__ __forceinline__ void onorm_phase(bf16_t* big, int ld, int ocol, int gcol, const float* gn, int dry) {
    const int tid_ = tidx(), lane = tid_ & 63, wv = bidx() * 8 + (tid_ >> 6), nw = gridDim.x * 8;
    constexpr int DV = RET ? 512 : 256, PER = DV / 64, NW = PER / 2;
    for (int r0 = wv; r0 < MT_; r0 += 2 * nw) {
        unsigned ow[2][4][NW], gw[2][4][NW];
#pragma unroll
        for (int u = 0; u < 2; ++u) { const int r = r0 + u * nw; if (r < MT_) {
#pragma unroll
            for (int h = 0; h < 4; ++h) {
                const bf16_t* op = big + (size_t)r * ld + ocol + h * DV + lane * PER; const bf16_t* gp = big + (size_t)r * ld + gcol + h * DV + lane * PER;
                if (RET) { const u32x4 a = *(const u32x4*)op, b = *(const u32x4*)gp; ow[u][h][0] = a.x; ow[u][h][1] = a.y; ow[u][h][2 % NW] = a.z; ow[u][h][3 % NW] = a.w; gw[u][h][0] = b.x; gw[u][h][1] = b.y; gw[u][h][2 % NW] = b.z; gw[u][h][3 % NW] = b.w; }
                else { const u32x2 a = *(const u32x2*)op, b = *(const u32x2*)gp; ow[u][h][0] = a.x; ow[u][h][1] = a.y; gw[u][h][0] = b.x; gw[u][h][1] = b.y; }
            } } }
#pragma unroll
        for (int u = 0; u < 2; ++u) { const int r = r0 + u * nw; if (r < MT_) {
#pragma unroll
            for (int h = 0; h < 4; ++h) {
                float o[PER], g[PER];
#pragma unroll
                for (int i = 0; i < NW; ++i) { o[2 * i] = bf_lo(ow[u][h][i]); o[2 * i + 1] = bf_hi(ow[u][h][i]); g[2 * i] = bf_lo(gw[u][h][i]); g[2 * i + 1] = bf_hi(gw[u][h][i]); }
                float sm = 0.f;
#pragma unroll
                for (int i = 0; i < PER; ++i) sm += RET ? o[i] : o[i] * o[i];
#pragma unroll
                for (int x = 32; x >= 1; x >>= 1) sm += __shfl_xor(sm, x);
                float mu = 0.f, rstd;
                if (RET) { mu = sm * (1.0f / DV); float q = 0.f;
#pragma unroll
                    for (int i = 0; i < PER; ++i) { const float d = o[i] - mu; q += d * d; }
#pragma unroll
                    for (int x = 32; x >= 1; x >>= 1) q += __shfl_xor(q, x);
                    rstd = rsqrtf(q * (1.0f / DV) + EPS);
                } else rstd = rsqrtf(sm * (1.0f / DV) + EPS);
                unsigned yw[NW];
#pragma unroll
                for (int i = 0; i < NW; ++i) { const f32x2 wv2 = *(const f32x2*)(gn + h * DV + lane * PER + 2 * i);
                    yw[i] = pk(silu(g[2 * i]) * ((o[2 * i] - mu) * rstd * wv2[0]), silu(g[2 * i + 1]) * ((o[2 * i + 1] - mu) * rstd * wv2[1])); }
                bf16_t* gp = big + (size_t)r * ld + gcol + h * DV + lane * PER;
                if (!dry) { if (RET) { u32x4 w4; w4.x = yw[0]; w4.y = yw[1]; w4.z = yw[2 % NW]; w4.w = yw[3 % NW]; *(u32x4*)gp = w4; }
                else { u32x2 w2; w2.x = yw[0]; w2.y = yw[1]; *(u32x2*)gp = w2; } }
            } } }
    }
}

constexpr int CSEG = 32, NSEGP = MP / CSEG, NSEG = NSEGP + 8;
__device__ __forceinline__ void halo_phase(const bf16_t* u, bf16_t* halo, float* convP, float* convS) {
    const int gtid = bidx() * 512 + tidx(), gthreads = gridDim.x * 512;
    for (int i = gtid; i < NSEGP * 704; i += gthreads) {
        const int sg = i / 704, p = i % 704; if ((sg & (SEQ / CSEG - 1)) == 0) continue;
        const int jj = p / 352, pc = p % 352;
        const u32x4 v = *(const u32x4*)(u + (size_t)(sg * CSEG - 2 + jj) * FF2 + pc * 8);
        *(u32x4*)(halo + ((size_t)sg * 2 + jj) * FF + pc * 8) = v;
    }
    for (int i = gtid; i < 16 * 2 * (FF2 / 2); i += gthreads) {
        const int c2 = i % (FF2 / 2), jj = (i / (FF2 / 2)) & 1, sq = i / FF2;
        const int row = sq < 8 ? sq * SEQ + SEQ - 2 + jj : MP + (sq - 8) * DSEQ + DSEQ - 2 + jj;
        const unsigned w = *(const unsigned*)(u + (size_t)row * FF2 + 2 * c2);
        float* dst = (sq < 8 ? convP + ((size_t)sq * 2 + jj) * FF2 : convS + ((size_t)(sq - 8) * 2 + jj) * FF2) + 2 * c2;
        *(f32x2*)dst = (f32x2){bf_lo(w), bf_hi(w)};
    }
}
__device__ __forceinline__ void conv_phase(bf16_t* u, const bf16_t* halo, const float* cw, const float* cb, const float* cache, int dry) {
    const int gtid = bidx() * 512 + tidx(), gthreads = gridDim.x * 512;
    for (int i = gtid; i < NSEG * (FF / 4); i += gthreads) {
        const int sg = i / (FF / 4), c = 4 * (i % (FF / 4));
        const bool samp = sg >= NSEGP; const int row0 = samp ? MP + (sg - NSEGP) * DSEQ : sg * CSEG;
        const f32x4 wg0 = *(const f32x4*)(cw + c), wg1 = *(const f32x4*)(cw + FF2 + c), wg2 = *(const f32x4*)(cw + 2 * FF2 + c), bg = *(const f32x4*)(cb + c);
        const f32x4 wv0 = *(const f32x4*)(cw + FF + c), wv1 = *(const f32x4*)(cw + FF2 + FF + c), wv2 = *(const f32x4*)(cw + 2 * FF2 + FF + c), bv = *(const f32x4*)(cb + FF + c);
        f32x4 g2, g1, v2, v1;
        if (samp) { const float* cs = cache + (size_t)(sg - NSEGP) * 2 * FF2; g2 = *(const f32x4*)(cs + c); g1 = *(const f32x4*)(cs + FF2 + c); v2 = *(const f32x4*)(cs + FF + c); v1 = *(const f32x4*)(cs + FF2 + FF + c); }
        else if ((sg & (SEQ / CSEG - 1)) == 0) { g2 = g1 = v2 = v1 = (f32x4){0.f, 0.f, 0.f, 0.f}; }
        else { g2 = bf4(*(const u32x2*)(halo + ((size_t)sg * 2) * FF + c)); g1 = bf4(*(const u32x2*)(halo + ((size_t)sg * 2 + 1) * FF + c));
            v2 = bf4(*(const u32x2*)(u + (size_t)(row0 - 2) * FF2 + FF + c)); v1 = bf4(*(const u32x2*)(u + (size_t)(row0 - 1) * FF2 + FF + c)); }
#pragma unroll 1
        for (int t0 = 0; t0 < CSEG; t0 += 8) {
            u32x2 gw[8], vw[8];
#pragma unroll
            for (int j = 0; j < 8; ++j) { const bf16_t* rp = u + (size_t)(row0 + t0 + j) * FF2 + c; gw[j] = *(const u32x2*)rp; vw[j] = *(const u32x2*)(rp + FF); }
            u32x2 ow[8];
#pragma unroll
            for (int j = 0; j < 8; ++j) {
                const f32x4 g0 = bf4(gw[j]), v0 = bf4(vw[j]);
                const f32x4 cgv = bg + g2 * wg0 + g1 * wg1 + g0 * wg2, cvv = bv + v2 * wv0 + v1 * wv1 + v0 * wv2;
                ow[j].x = pk(silu(cgv[0]) * cvv[0], silu(cgv[1]) * cvv[1]); ow[j].y = pk(silu(cgv[2]) * cvv[2], silu(cgv[3]) * cvv[3]);
                g2 = g1; g1 = g0; v2 = v1; v1 = v0;
            }
#pragma unroll
            for (int j = 0; j < 8; ++j) if (!dry) *(u32x2*)(u + (size_t)(row0 + t0 + j) * FF2 + c) = ow[j];
        }
    }
}

__device__ __forceinline__ void glaprep_phase(bf16_t* big, const bf16_t* a16, const float* w_a2, const float* b_a, float* eb, int dry) {
    const int gtid = bidx() * 512 + tidx(), gthreads = gridDim.x * 512;
    for (int i = gtid; i < NCHUNK * 128; i += gthreads) {
        const int ch = i >> 7, c = 4 * (i & 127);
        const bool samp = ch >= 1024; const int row0 = samp ? MP + (ch - 1024) * DSEQ : ch * 64; const int len = samp ? DSEQ : 64;
        f32x4 W[16];
#pragma unroll
        for (int r = 0; r < 16; ++r) W[r] = *(const f32x4*)(w_a2 + r * 512 + c);
        const f32x4 bias = *(const f32x4*)(b_a + c);
        f32x4 b = {0.f, 0.f, 0.f, 0.f};
#pragma unroll 1
        for (int t0 = 0; t0 < len; t0 += 8) {
            u32x4 aw[8][2]; u32x2 qw[8], kw[8];
#pragma unroll
            for (int j = 0; j < 8; ++j) { const size_t r = row0 + t0 + j; aw[j][0] = *(const u32x4*)(a16 + r * 16); aw[j][1] = *(const u32x4*)(a16 + r * 16 + 8); qw[j] = *(const u32x2*)(big + r * GLA_NB + c); kw[j] = *(const u32x2*)(big + r * GLA_NB + 512 + c); }
#pragma unroll
            for (int j = 0; j < 8; ++j) { const size_t r = row0 + t0 + j;
                const unsigned aa[8] = {aw[j][0].x, aw[j][0].y, aw[j][0].z, aw[j][0].w, aw[j][1].x, aw[j][1].y, aw[j][1].z, aw[j][1].w};
                f32x4 z = bias;
#pragma unroll
                for (int x = 0; x < 8; ++x) { z += W[2 * x] * bf_lo(aa[x]); z += W[2 * x + 1] * bf_hi(aa[x]); }
#pragma unroll
                for (int x = 0; x < 4; ++x) b[x] += (fminf(z[x], 0.f) - __logf(1.0f + __expf(-fabsf(z[x])))) * 0.0625f;
                const f32x4 q = bf4(qw[j]), k = bf4(kw[j]); f32x4 e, ie;
#pragma unroll
                for (int x = 0; x < 4; ++x) { e[x] = __expf(b[x]); ie[x] = __expf(-b[x]); }
                u32x2 w; w.x = pk(q[0] * e[0], q[1] * e[1]); w.y = pk(q[2] * e[2], q[3] * e[3]); if (!dry) *(u32x2*)(big + r * GLA_NB + c) = w;
                w.x = pk(k[0] * ie[0], k[1] * ie[1]); w.y = pk(k[2] * ie[2], k[3] * ie[3]); if (!dry) *(u32x2*)(big + r * GLA_NB + 512 + c) = w; }
        }
        f32x4 e;
#pragma unroll
        for (int x = 0; x < 4; ++x) e[x] = __expf(b[x]);
        *(f32x4*)(eb + (size_t)ch * 512 + c) = e;
    }
}

struct ScanArgs { bf16_t* big; int ld, qoff, koff, voff; const float* eb; const float* S0; float* SoutP; float* SoutS; };
template <int DK, int DV, int NCG, bool GLA>
__device__ __forceinline__ void scan_phase(LAS unsigned char* lds, const ScanArgs& a) {
    constexpr int NTG = 8 / NCG, TW = 64 / NTG, MT = TW / 16, NT = DK / 16, KS = DK / 32, QP = DK + 8, TP = 72, SLICE = 16 * NCG, NS = DV / SLICE, VP = SLICE + 8;
    constexpr int NTL = NT / NTG, KSL = KS / NTG, DKL = DK / NTG;
    constexpr int NPQ = DK / 64;
    static_assert(NS == 8 && KSL >= 1 && NTL == 2 * KSL, "scan geometry");
    LAS bf16_t* Qs = (LAS bf16_t*)lds; LAS bf16_t* Ks = Qs + 64 * QP; LAS bf16_t* Vs = Ks + 64 * QP; LAS bf16_t* Ps = Vs + 64 * VP;
    LAS f32x4* XCH = (LAS f32x4*)(Ps + 64 * TP);
    static_assert(((64 * QP * 2 + 64 * VP + 64 * TP) * 2) % 16 == 0 && (64 * QP * 2 + 64 * VP + 64 * TP) * 2 + 8 * 4 * 64 * 16 <= LDS_MAIN, "scan LDS");
    const int tid = tidx(), bid = bidx(), wave = __builtin_amdgcn_readfirstlane(tid >> 6), lane = tid & 63, fr = lane & 15, fq = lane >> 4;
    const int cgi = wave % NCG, tg = wave / NCG;
    const int trK = (8 * fq + (fr >> 2)) * QP + 4 * (fr & 3), trV = (8 * fq + (fr >> 2)) * VP + 4 * (fr & 3);
#define TR_FRAG(ptr, pitch) ({ const s16x4 lo_ = __builtin_amdgcn_ds_read_tr16_b64_v4i16((LAS s16x4*)(ptr)), hi_ = __builtin_amdgcn_ds_read_tr16_b64_v4i16((LAS s16x4*)((ptr) + 4 * (pitch))); (bf16x8)__builtin_shufflevector(lo_, hi_, 0, 1, 2, 3, 4, 5, 6, 7); })
    for (int ui = 0; ui < 2; ++ui) {
        const bool samp = ui == 1;
        const int x = bid & 7, j = bid >> 3;
        const int bh = x + 8 * (j >> 3), s = j & 7, b = bh >> 2, h = bh & 3;
        if (bh >= 32) continue;
        const int row0 = samp ? MP + b * DSEQ : b * SEQ, L = samp ? DSEQ : 64, nch = samp ? 1 : SEQ / 64;
        const bf16_t* qb = a.big + a.qoff + h * DK; const bf16_t* kb = a.big + a.koff + h * DK; bf16_t* vb = a.big + a.voff + h * DV + s * SLICE;
        f32x4 S[NTL];
        int loff = (DKL * tg + 4 * fq) * DV + 16 * cgi + fr;
        asm volatile("" : "+v"(loff));
        if (samp) {
            const float* s0 = a.S0 + (size_t)(b * 4 + h) * DK * DV + s * SLICE + loff;
#pragma unroll
            for (int t = 0; t < NTL; ++t)
#pragma unroll
                for (int r = 0; r < 4; ++r) S[t][r] = s0[(16 * t + r) * DV];
        } else {
#pragma unroll
            for (int t = 0; t < NTL; ++t) S[t] = (f32x4){0.f, 0.f, 0.f, 0.f};
        }
        const float lgam = h == 0 ? -0.031748698314580f : h == 1 ? -0.015748356968139f : h == 2 ? -0.007843177461025f : -0.003913899321136f;
        const float dsc = __expf((float)L * lgam);
        u32x4 qreg[NPQ], kreg[NPQ], vreg;
        f32x4 dreg[GLA ? NTL : 1];
#define SCAN_LOAD(c) do { const size_t rc = (size_t)row0 + (size_t)(c) * 64; \
        _Pragma("unroll") for (int i = 0; i < NPQ; ++i) { const int p = tid + 512 * i; const int t = p / (DK / 8), dg = p % (DK / 8); \
            qreg[i] = t < L ? *(const u32x4*)(qb + (rc + t) * a.ld + 8 * dg) : (u32x4){0u, 0u, 0u, 0u}; } \
        _Pragma("unroll") for (int i = 0; i < NPQ; ++i) { const int p = tid + 512 * i; const int t = p / (DK / 8), dg = p % (DK / 8); \
            kreg[i] = t < L ? *(const u32x4*)(kb + (rc + t) * a.ld + 8 * dg) : (u32x4){0u, 0u, 0u, 0u}; } \
        { const int t = tid / (SLICE / 8), cp = tid % (SLICE / 8); vreg = (t < 64 && t < L) ? *(const u32x4*)(vb + (rc + t) * a.ld + 8 * cp) : (u32x4){0u, 0u, 0u, 0u}; } \
        if (GLA) { const float* ebp = a.eb + (size_t)(samp ? 1024 + b : b * 128 + (c)) * 512 + h * DK + DKL * tg; \
            _Pragma("unroll") for (int t = 0; t < (GLA ? NTL : 1); ++t) dreg[t] = *(const f32x4*)(ebp + 16 * t + 4 * fq); } } while (0)
        SCAN_LOAD(0);
        for (int c = 0; c < nch; ++c) {
#pragma unroll
            for (int i = 0; i < NPQ; ++i) { const int p = tid + 512 * i; const int t = p / (DK / 8), dg = p % (DK / 8); *(LAS u32x4*)(Qs + t * QP + 8 * dg) = qreg[i]; }
#pragma unroll
            for (int i = 0; i < NPQ; ++i) { const int p = tid + 512 * i; const int t = p / (DK / 8), dg = p % (DK / 8); *(LAS u32x4*)(Ks + t * QP + 8 * dg) = kreg[i]; }
            { const int t = tid / (SLICE / 8), cp = tid % (SLICE / 8); if (t < 64) *(LAS u32x4*)(Vs + t * VP + 8 * cp) = vreg; }
            f32x4 dcur[GLA ? NTL : 1];
#pragma unroll
            for (int t = 0; t < (GLA ? NTL : 1); ++t) dcur[t] = dreg[t];
            __syncthreads();
            if (c + 1 < nch) SCAN_LOAD(c + 1);
#pragma unroll
            for (int tt = 0; tt < 2; ++tt) {
                const int t = wave + 8 * tt, it = t >> 2, jt = t & 3;
                f32x4 p = {0.f, 0.f, 0.f, 0.f};
                if (jt <= it) {
#pragma unroll
                    for (int ks = 0; ks < KS; ++ks) {
                        const bf16x8 ak = *(const LAS bf16x8*)(Ks + (16 * jt + fr) * QP + 32 * ks + 8 * fq);
                        const bf16x8 bq = *(const LAS bf16x8*)(Qs + (16 * it + fr) * QP + 32 * ks + 8 * fq);
                        p = MFMA16(ak, bq, p);
                        if ((ks & 3) == 3) asm volatile("" ::: "memory");
                    }
                    if (jt == it) {
#pragma unroll
                        for (int r = 0; r < 4; ++r) if (4 * fq + r > fr) p[r] = 0.f;
                    }
                }
                u32x2 w; w.x = pk(p[0], p[1]); w.y = pk(p[2], p[3]);
                *(LAS u32x2*)(Ps + (16 * it + fr) * TP + 16 * jt + 4 * fq) = w;
            }
            f32x4 op[4];
#pragma unroll
            for (int i = 0; i < 4; ++i) op[i] = (f32x4){0.f, 0.f, 0.f, 0.f};
#pragma unroll
            for (int ks = 0; ks < KSL; ++ks) {
                u32x4 sp; sp.x = pk(S[2 * ks][0], S[2 * ks][1]); sp.y = pk(S[2 * ks][2], S[2 * ks][3]); sp.z = pk(S[2 * ks + 1][0], S[2 * ks + 1][1]); sp.w = pk(S[2 * ks + 1][2], S[2 * ks + 1][3]);
                const bf16x8 sa = __builtin_bit_cast(bf16x8, sp);
#pragma unroll
                for (int i = 0; i < 4; ++i) {
                    const int tt = (MT * tg + i) & 3;
                    const LAS bf16_t* qp = Qs + (16 * tt + fr) * QP + DKL * tg + 32 * ks + 4 * fq;
                    const s16x4 lo = *(const LAS s16x4*)qp, hi = *(const LAS s16x4*)(qp + 16);
                    const bf16x8 bq = __builtin_shufflevector(lo, hi, 0, 1, 2, 3, 4, 5, 6, 7);
                    op[i] = MFMA16(sa, bq, op[i]);
                }
                asm volatile("" ::: "memory");
            }
#pragma unroll
            for (int i = MT; i < 4; ++i) { const int tt = (MT * tg + i) & 3; XCH[(wave * 4 + tt) * 64 + lane] = op[i]; }
            __syncthreads();
            f32x4 o[MT];
#pragma unroll
            for (int mt = 0; mt < MT; ++mt) {
                o[mt] = op[mt];
#pragma unroll
                for (int d = 1; d < NTG; ++d) { const int pw = cgi + NCG * ((tg + d) % NTG); o[mt] += XCH[(pw * 4 + MT * tg + mt) * 64 + lane]; }
            }
            bf16x8 vt[2];
#pragma unroll
            for (int ks = 0; ks < 2; ++ks) vt[ks] = TR_FRAG(Vs + trV + 32 * ks * VP + 16 * cgi, VP);
#pragma unroll
            for (int mt = 0; mt < MT; ++mt)
#pragma unroll
                for (int ks = 0; ks < 2; ++ks) {
                    const bf16x8 bp = *(const LAS bf16x8*)(Ps + (TW * tg + 16 * mt + fr) * TP + 32 * ks + 8 * fq);
                    o[mt] = MFMA16(vt[ks], bp, o[mt]);
                }
#pragma unroll
            for (int mt = 0; mt < MT; ++mt) {
                const int tok = TW * tg + 16 * mt + fr;
                if (tok < L) { u32x2 w; w.x = pk(o[mt][0], o[mt][1]); w.y = pk(o[mt][2], o[mt][3]);
                    *(u32x2*)(vb + ((size_t)row0 + (size_t)c * 64 + tok) * a.ld + 16 * cgi + 4 * fq) = w; }
            }
#pragma unroll
            for (int t = 0; t < NTL; ++t) {
#pragma unroll
                for (int ks = 0; ks < 2; ++ks) {
                    const bf16x8 ak = TR_FRAG(Ks + trK + 32 * ks * QP + DKL * tg + 16 * t, QP);
                    S[t] = MFMA16(ak, vt[ks], S[t]);
                }
                if (GLA) S[t] = S[t] * dcur[GLA ? t : 0]; else S[t] = S[t] * dsc;
                if (t & 1) asm volatile("" ::: "memory");
            }
            __syncthreads();
        }
#undef SCAN_LOAD
        {
            int loff2 = (DKL * tg + 4 * fq) * DV + 16 * cgi + fr;
            asm volatile("" : "+v"(loff2));
            float* so = (samp ? a.SoutS : a.SoutP) + (size_t)(b * 4 + h) * DK * DV + s * SLICE + loff2;
#pragma unroll
            for (int t = 0; t < NTL; ++t)
#pragma unroll
                for (int r = 0; r < 4; ++r) so[(16 * t + r) * DV] = S[t][r];
        }
    }
}

constexpr int NPHASE = 20;
constexpr int LDS_BYTES = LDS_MAIN + 16;

typedef const __attribute__((address_space(4))) Args* KArgs;
#define ARGS() ({ KArgs p_ = ka0; asm volatile("" : "+s"(p_)); p_; })
#ifndef PROBE_MASK
#define PROBE_MASK 0
#endif
#define REP(bit, body) do { for (int rp_ = (PROBE_MASK >> (bit)) & 1; rp_ >= 0; --rp_) { const int dry = rp_; (void)dry; body; if (rp_) xcd_barrier(bar); } } while (0)

__global__ void __launch_bounds__(512, 2) mk_fwd(Args a_unused) {
    extern __shared__ __attribute__((aligned(16))) unsigned char lds_raw[];
    LAS unsigned char* lds = (LAS unsigned char*)lds_raw;
    const KArgs ka0 = (KArgs)__builtin_amdgcn_kernarg_segment_ptr();
    const int lo = ka0->ph_lo, hi = ka0->ph_hi;
    XcdBarrier bar; bar.bar = (unsigned*)ka0->ws; bar.x = 0; bar.st = (volatile LAS unsigned*)(lds + LDS_MAIN);
    if (hi - lo > 1) {
        if (threadIdx.x < 4) ((LAS unsigned*)(lds + LDS_MAIN))[threadIdx.x] = 0u;
        __syncthreads();
        bar = xcd_barrier_post((unsigned*)ka0->ws, (volatile LAS unsigned*)(lds + LDS_MAIN));
    }
#define IN(k) (lo <= (k) && (k) < hi)
#define SEAM(k) do { if (IN(k) && IN((k) + 1)) { xcd_barrier(bar); } } while (0)
#define WSP(off) (A->ws + (off))
#define XRES (A->out)
    if (IN(0)) { KArgs A = ARGS(); Args av;
#pragma unroll
        for (int i = 0; i < 20; ++i) av.in[i] = A->in[i];
        av.out = A->out; av.ws = A->ws; av.ph_lo = 0; av.ph_hi = 0; REP(0, prep_phase(lds, av)); }
    if (lo < -1) cg::this_grid().sync();
    SEAM(0);
    if (IN(1)) { KArgs A = ARGS(); pg8::Gemm g{(const bf16_t*)WSP(WS_H), (const bf16_t*)WSP(WS_WRI), MT_, RET_N, 1024, 1024}; pg8::StaticOrder S; S.init(MT_, RET_N, 1024, gridDim.x, bidx(), 0);
        Epi<1> E{}; E.O = (bf16_t*)WSP(WS_BIG); E.ldc = RET_N; E.rot = (const f32x2*)WSP(WS_ROT); REP(1, pg8::gemm_phase(lds, g, S, E));
        { const int b_ = bidx(); if (b_ >= 24) { Args av;
#pragma unroll
            for (int i = 0; i < 20; ++i) av.in[i] = A->in[i];
            av.out = A->out; av.ws = A->ws; av.ph_lo = 0; av.ph_hi = 0; weight_jobs(lds, av, 1, b_ - 24, (int)gridDim.x - 24); } } } SEAM(1);
    if (IN(2)) { KArgs A = ARGS(); ScanArgs sa{(bf16_t*)WSP(WS_BIG), RET_N, 0, 1024, 2048, nullptr, A->in[2], A->out + O_RETP, A->out + O_RETS}; scan_phase<256, 512, 4, false>(lds, sa); } SEAM(2);
    if (IN(3)) { KArgs A = ARGS(); REP(2, onorm_phase<true>((bf16_t*)WSP(WS_BIG), RET_N, 2048, 4096, A->in[9], dry)); } SEAM(3);
    if (IN(4)) { KArgs A = ARGS(); pg8::Gemm g{(const bf16_t*)WSP(WS_BIG) + 4096, (const bf16_t*)WSP(WS_WRO), MT_, 1024, 2048, RET_N}; pg8::StaticOrder S; S.init(MT_, 1024, 2048, gridDim.x, bidx(), 4);
        Epi<2> E{}; E.resP = A->in[0]; E.resS = A->in[1]; E.tmp = (float*)WSP(WS_TMP); E.xb = (bf16_t*)WSP(WS_H); E.ssw = (float*)WSP(WS_SSP); pg8::gemm_phase(lds, g, S, E); } SEAM(4);
#pragma unroll 1
    for (int l = 0; l < 2; ++l) {
        const int pb = l == 0 ? 5 : 15;
        if (IN(pb)) { KArgs A = ARGS(); samplenorm_phase((bf16_t*)WSP(WS_H) + (size_t)MP * DM, (float*)WSP(WS_SS) + (size_t)(2 * l) * MT_ + MP, (const float*)WSP(WS_TMP), (const float*)WSP(WS_SSP)); } SEAM(pb);
        if (IN(pb + 1)) { KArgs A = ARGS(); pg8::Gemm g{(const bf16_t*)WSP(WS_H), (const bf16_t*)WSP(WS_WUP) + (size_t)l * FF2 * 1024, MT_, FF2, 1024, 1024}; pg8::StaticOrder S; S.init(MT_, FF2, 1024, gridDim.x, bidx(), 5);
            EpiConv E{(bf16_t*)WSP(WS_ACT), (bf16_t*)WSP(WS_HEAD), (bf16_t*)WSP(WS_EDGE), A->in[17] + (size_t)l * 3 * FF2, A->in[18] + (size_t)l * FF2, (float*)WSP(WS_USLAB), (const float*)WSP(WS_SS) + (size_t)(2 * l) * MT_}; pg8::gemm_phase(lds, g, S, E); } SEAM(pb + 1);
        if (IN(pb + 2)) { KArgs A = ARGS(); convfix_phase((bf16_t*)WSP(WS_ACT), (const bf16_t*)WSP(WS_HEAD), (const bf16_t*)WSP(WS_EDGE), A->in[17] + (size_t)l * 3 * FF2, A->in[18] + (size_t)l * FF2, A->in[4] + (size_t)l * 8 * 2 * FF2,
            A->out + O_CONVP + (size_t)l * 8 * 2 * FF2, A->out + O_CONVS + (size_t)l * 8 * 2 * FF2, (const float*)WSP(WS_USLAB), (const float*)WSP(WS_SS) + (size_t)(2 * l) * MT_); } SEAM(pb + 2);
        if (IN(pb + 3)) { KArgs A = ARGS(); pg8::Gemm g{(const bf16_t*)WSP(WS_ACT), (const bf16_t*)WSP(WS_WDN) + (size_t)l * 1024 * FF, MT_, 1024, FF, FF}; pg8::StaticOrder S; S.init(MT_, 1024, FF, gridDim.x, bidx(), 4);
            Epi<2> E{}; E.tmp = (float*)WSP(WS_TMP); E.xb = (bf16_t*)WSP(WS_H); if (l == 0) E.ssw = (float*)WSP(WS_SSP); pg8::gemm_phase(lds, g, S, E); } SEAM(pb + 3);
        if (l == 0) {
            if (IN(9)) { KArgs A = ARGS(); samplenorm_phase((bf16_t*)WSP(WS_H) + (size_t)MP * DM, (float*)WSP(WS_SS) + MT_ + MP, (const float*)WSP(WS_TMP), (const float*)WSP(WS_SSP)); } SEAM(9);
            if (IN(10)) { KArgs A = ARGS(); pg8::Gemm g{(const bf16_t*)WSP(WS_H), (const bf16_t*)WSP(WS_WGI), MT_, GLA_N, 1024, 1024}; pg8::StaticOrder S; S.init(MT_, GLA_N, 1024, gridDim.x, bidx(), 0);
                Epi<3> E{}; E.O = (bf16_t*)WSP(WS_BIG); E.ldc = GLA_NB; E.lg = (bf16_t*)WSP(WS_LG); E.b_a = A->in[13]; E.ssr = (const float*)WSP(WS_SS) + MT_; pg8::gemm_phase(lds, g, S, E);
                { const int b_ = bidx(); if (b_ >= 13) { Args av;
#pragma unroll
                    for (int i = 0; i < 20; ++i) av.in[i] = A->in[i];
                    av.out = A->out; av.ws = A->ws; av.ph_lo = 0; av.ph_hi = 0; weight_jobs(lds, av, 2, b_ - 13, (int)gridDim.x - 13); } } } SEAM(10);
            if (IN(11)) { KArgs A = ARGS(); REP(6, glaprep_phase((bf16_t*)WSP(WS_BIG), (const bf16_t*)WSP(WS_LG), A->in[12], A->in[13], (float*)WSP(WS_EB), dry)); } SEAM(11);
            if (IN(12)) { KArgs A = ARGS(); ScanArgs sa{(bf16_t*)WSP(WS_BIG), GLA_NB, 0, 512, 1024, (const float*)WSP(WS_EB), A->in[3], A->out + O_GLAP, A->out + O_GLAS}; scan_phase<128, 256, 2, true>(lds, sa); } SEAM(12);
            if (IN(13)) { KArgs A = ARGS(); REP(2, onorm_phase<false>((bf16_t*)WSP(WS_BIG), GLA_NB, 1024, 2048, A->in[14], dry)); } SEAM(13);
            if (IN(14)) { KArgs A = ARGS(); pg8::Gemm g{(const bf16_t*)WSP(WS_BIG) + 2048, (const bf16_t*)WSP(WS_WGO), MT_, 1024, 1024, GLA_NB}; pg8::StaticOrder S; S.init(MT_, 1024, 1024, gridDim.x, bidx(), 4);
                Epi<2> E{}; E.tmp = (float*)WSP(WS_TMP); E.xb = (bf16_t*)WSP(WS_H); E.ssw = (float*)WSP(WS_SSP); pg8::gemm_phase(lds, g, S, E); } SEAM(14);
        }
    }
    if (IN(19)) { KArgs A = ARGS(); REP(7, final_norm_phase((const bf16_t*)WSP(WS_H), A->out, A->in[7], dry, (const float*)WSP(WS_TMP))); }
#undef IN
#undef SEAM
}

extern "C" void kernel_launch(void* const* d_in, const int* in_sizes, int n_in, void* d_out, int out_size, void* d_ws, size_t ws_size, hipStream_t stream) {
    static int grid = 0;
    if (grid == 0) {
        if (n_in != 20 || (size_t)out_size != O_END || ws_size < WS_END) { fprintf(stderr, "kernel_launch: unexpected shapes (n_in %d out %d ws %zu need %zu)\n", n_in, out_size, ws_size, (size_t)WS_END); grid = -1; return; }
        if (hipFuncSetAttribute((const void*)mk_fwd, hipFuncAttributeMaxDynamicSharedMemorySize, LDS_BYTES) != hipSuccess) { fprintf(stderr, "kernel_launch: hipFuncSetAttribute failed\n"); grid = -1; return; }
        int dev = 0, cus = 0, per_cu = 0;
        hipGetDevice(&dev); hipDeviceGetAttribute(&cus, hipDeviceAttributeMultiprocessorCount, dev);
        hipOccupancyMaxActiveBlocksPerMultiprocessor(&per_cu, (const void*)mk_fwd, 512, LDS_BYTES);
        if (per_cu < 1) { fprintf(stderr, "kernel_launch: occupancy query says %d blocks/CU\n", per_cu); per_cu = 1; }
        (void)hipGetLastError();
        grid = cus;
    }
    if (grid < 0) return;
    if (hipMemsetAsync(d_ws, 0, 16384, stream) != hipSuccess) { fprintf(stderr, "kernel_launch: memset failed\n"); return; }
    Args a{};
    for (int i = 0; i < 20; ++i) a.in[i] = (const float*)d_in[i];
    a.out = (float*)d_out; a.ws = (unsigned char*)d_ws;
#if MK_ONE_LAUNCH
    a.ph_lo = 0; a.ph_hi = NPHASE;
    void* args[] = {&a};
    hipError_t e = hipLaunchCooperativeKernel((const void*)mk_fwd, dim3(grid), dim3(512), args, LDS_BYTES, stream);
    if (e != hipSuccess) fprintf(stderr, "cooperative launch failed: %s (grid %d)\n", hipGetErrorString(e), grid);
#else
    for (int p = 0; p < NPHASE; ++p) {
        a.ph_lo = p; a.ph_hi = p + 1;
        hipLaunchKernelGGL(mk_fwd, dim3(grid), dim3(512), LDS_BYTES, stream, a);
    }
#endif
}
```
